# Optimizing an MI355X kernel written in HIP

```python
import jax, jax.numpy as jnp
from jax import lax
import numpy as np

D_MODEL = 1024
BATCH = 4
SEQ = 8192
DEPTH = 1

CHUNK = 64
GMLP_BLOCK = 128
GMLP_GROUP_DIM = 128
GMLP_WIDTH = D_MODEL
GMLP_GROUPS = GMLP_WIDTH // GMLP_GROUP_DIM
S5_GROUP_DIM = 16
S5_WIDTH = D_MODEL // 2
S5_GROUPS = S5_WIDTH // S5_GROUP_DIM
S5_STATE = 64
N_BRANCHES = 2
IN_WIDTH = 2 * GMLP_WIDTH + S5_WIDTH + N_BRANCHES * D_MODEL
FFN_HIDDEN = -(-8 * D_MODEL // 768) * 256
DT_MIN = 1e-3
DT_MAX = 1e-1
EPS = 1e-6

kernel_name = "hybrid_gmlp_s5_gated_streaming_block"


def rms_norm(x, g):
    xf = x.astype(jnp.float32)
    y = xf * lax.rsqrt(jnp.mean(xf * xf, axis=-1, keepdims=True) + EPS)
    return (y * g.astype(jnp.float32)).astype(x.dtype)


def layer_norm(x, g, b):
    xf = x.astype(jnp.float32)
    mu = jnp.mean(xf, axis=-1, keepdims=True)
    xc = xf - mu
    y = xc * lax.rsqrt(jnp.mean(xc * xc, axis=-1, keepdims=True) + EPS)
    return (y * g.astype(jnp.float32) + b.astype(jnp.float32)).astype(x.dtype)


def gmlp_mixer(u, v, ln_g, ln_b, ws, bs):
    bsz, length, _ = u.shape
    u = jax.nn.gelu(u)
    v = layer_norm(jax.nn.gelu(v), ln_g, ln_b)
    cidx = jnp.arange(GMLP_BLOCK) // CHUNK
    mask = cidx[None, :] <= cidx[:, None]
    ws_m = jnp.where(mask[None], ws, jnp.zeros_like(ws))
    vb = v.reshape(bsz, length // GMLP_BLOCK, GMLP_BLOCK, GMLP_GROUPS, GMLP_GROUP_DIM)
    mixed = jnp.einsum('gij,bnjgc->bnigc', ws_m, vb) + bs.T[:, :, None]
    return u * mixed.reshape(bsz, length, GMLP_WIDTH)


def _ssm_combine(e1, e2):
    a1r, a1i, b1r, b1i = e1
    a2r, a2i, b2r, b2i = e2
    return (a2r * a1r - a2i * a1i,
            a2r * a1i + a2i * a1r,
            a2r * b1r - a2i * b1i + b2r,
            a2r * b1i + a2i * b1r + b2i)


def s5_mixer(xb, lam_re, lam_im, log_dt, b_re, b_im, c_re, c_im, d, w_glu, b_glu):
    dtype = xb.dtype
    f32 = jnp.float32
    bsz, length, _ = xb.shape
    dt = jnp.exp(log_dt.astype(f32))[:, None]
    lr = lam_re.astype(f32)
    li = lam_im.astype(f32)
    mag = jnp.exp(lr * dt)
    ab_re = mag * jnp.cos(li * dt)
    ab_im = mag * jnp.sin(li * dt)
    den = lr * lr + li * li
    nr = ab_re - 1.0
    coef_re = (nr * lr + ab_im * li) / den
    coef_im = (ab_im * lr - nr * li) / den
    br = b_re.astype(f32)
    bi = b_im.astype(f32)
    bb_re = coef_re[..., None] * br - coef_im[..., None] * bi
    bb_im = coef_re[..., None] * bi + coef_im[..., None] * br
    cr = c_re.astype(f32)
    ci = c_im.astype(f32)
    df = d.astype(f32)

    u = xb.astype(f32).reshape(bsz, length // CHUNK, CHUNK, S5_GROUPS, S5_GROUP_DIM)
    u = u.transpose(1, 0, 2, 3, 4)

    def step(carry, u_c):
        h_re, h_im = carry
        bu_re = jnp.einsum('bcgh,gph->bcgp', u_c, bb_re)
        bu_im = jnp.einsum('bcgh,gph->bcgp', u_c, bb_im)
        a_re = jnp.broadcast_to(ab_re, bu_re.shape)
        a_im = jnp.broadcast_to(ab_im, bu_im.shape)
        pr, pim, xr, xi = lax.associative_scan(_ssm_combine, (a_re, a_im, bu_re, bu_im), axis=1)
        xr = xr + pr * h_re[:, None] - pim * h_im[:, None]
        xi = xi + pr * h_im[:, None] + pim * h_re[:, None]
        y = (jnp.einsum('bcgp,ghp->bcgh', xr, cr)
             - jnp.einsum('bcgp,ghp->bcgh', xi, ci)
             + df * u_c)
        return (xr[:, -1], xi[:, -1]), y

    h0 = jnp.zeros((bsz, S5_GROUPS, S5_STATE), f32)
    _, ys = lax.scan(step, (h0, h0), u)
    y = ys.transpose(1, 0, 2, 3, 4).reshape(bsz, length, S5_WIDTH)
    y = jax.nn.gelu(y)
    y = y * jax.nn.sigmoid(y @ w_glu.astype(f32) + b_glu.astype(f32))
    return y.astype(dtype)


def hybrid_layer(x, norm1_g, w_in, gmlp_ln_g, gmlp_ln_b, gmlp_ws, gmlp_bs,
                 s5_lambda_re, s5_lambda_im, s5_log_dt, s5_b_re, s5_b_im, s5_c_re, s5_c_im,
                 s5_d, s5_w_glu, s5_b_glu, w_branch_a, w_branch_b, w_out,
                 norm2_g, w_ffn_gate, w_ffn_up, w_ffn_down):
    h = rms_norm(x, norm1_g)
    proj = h @ w_in
    s1 = GMLP_WIDTH
    s2 = 2 * GMLP_WIDTH
    s3 = s2 + S5_WIDTH
    s4 = s3 + D_MODEL
    u_a = proj[..., :s1]
    v_a = proj[..., s1:s2]
    x_b = proj[..., s2:s3]
    g_a = proj[..., s3:s4]
    g_b = proj[..., s4:]
    y_a = gmlp_mixer(u_a, v_a, gmlp_ln_g, gmlp_ln_b, gmlp_ws, gmlp_bs)
    y_b = s5_mixer(x_b, s5_lambda_re, s5_lambda_im, s5_log_dt, s5_b_re, s5_b_im,
                   s5_c_re, s5_c_im, s5_d, s5_w_glu, s5_b_glu)
    merged = jax.nn.sigmoid(g_a) * (y_a @ w_branch_a) + jax.nn.sigmoid(g_b) * (y_b @ w_branch_b)
    x = x + merged @ w_out
    h2 = rms_norm(x, norm2_g)
    x = x + (jax.nn.silu(h2 @ w_ffn_gate) * (h2 @ w_ffn_up)) @ w_ffn_down
    return x


def setup_inputs(seed: int = 0) -> dict:
    key = jax.random.key(seed)
    ks = jax.random.split(key, 32)
    f32 = jnp.float32
    L = DEPTH
    G, P, H = S5_GROUPS, S5_STATE, S5_GROUP_DIM
    nrm = lambda k, shape, s: jax.random.normal(k, shape, f32) * s
    log_dt = jax.random.uniform(ks[9], (L, G), f32, np.log(DT_MIN), np.log(DT_MAX))
    return {
        "x": jax.random.normal(ks[0], (BATCH, SEQ, D_MODEL), f32),
        "norm1_g": 1.0 + nrm(ks[1], (L, D_MODEL), 0.01),
        "w_in": nrm(ks[2], (L, D_MODEL, IN_WIDTH), D_MODEL ** -0.5),
        "gmlp_ln_g": 1.0 + nrm(ks[3], (L, GMLP_WIDTH), 0.01),
        "gmlp_ln_b": nrm(ks[4], (L, GMLP_WIDTH), 0.01),
        "gmlp_ws": nrm(ks[5], (L, GMLP_GROUPS, GMLP_BLOCK, GMLP_BLOCK), GMLP_BLOCK ** -0.5),
        "gmlp_bs": 1.0 + nrm(ks[6], (L, GMLP_GROUPS, GMLP_BLOCK), 0.01),
        "s5_lambda_re": -0.5 + nrm(ks[7], (L, G, P), 0.01),
        "s5_lambda_im": jnp.broadcast_to(np.pi * jnp.arange(P, dtype=f32), (L, G, P)) + nrm(ks[8], (L, G, P), 0.01),
        "s5_log_dt": log_dt,
        "s5_b_re": nrm(ks[10], (L, G, P, H), (2.0 * H) ** -0.5),
        "s5_b_im": nrm(ks[11], (L, G, P, H), (2.0 * H) ** -0.5),
        "s5_c_re": nrm(ks[12], (L, G, H, P), (2.0 * P) ** -0.5),
        "s5_c_im": nrm(ks[13], (L, G, H, P), (2.0 * P) ** -0.5),
        "s5_d": nrm(ks[14], (L, G, H), 1.0),
        "s5_w_glu": nrm(ks[15], (L, S5_WIDTH, S5_WIDTH), S5_WIDTH ** -0.5),
        "s5_b_glu": nrm(ks[16], (L, S5_WIDTH), 0.01),
        "w_branch_a": nrm(ks[17], (L, GMLP_WIDTH, D_MODEL), GMLP_WIDTH ** -0.5),
        "w_branch_b": nrm(ks[18], (L, S5_WIDTH, D_MODEL), S5_WIDTH ** -0.5),
        "w_out": nrm(ks[19], (L, D_MODEL, D_MODEL), D_MODEL ** -0.5),
        "norm2_g": 1.0 + nrm(ks[20], (L, D_MODEL), 0.01),
        "w_ffn_gate": nrm(ks[21], (L, D_MODEL, FFN_HIDDEN), D_MODEL ** -0.5),
        "w_ffn_up": nrm(ks[22], (L, D_MODEL, FFN_HIDDEN), D_MODEL ** -0.5),
        "w_ffn_down": nrm(ks[23], (L, FFN_HIDDEN, D_MODEL), FFN_HIDDEN ** -0.5),
        "norm_f_g": 1.0 + nrm(ks[24], (D_MODEL,), 0.01),
    }


def reference(x, norm1_g, w_in, gmlp_ln_g, gmlp_ln_b, gmlp_ws, gmlp_bs,
              s5_lambda_re, s5_lambda_im, s5_log_dt, s5_b_re, s5_b_im, s5_c_re, s5_c_im,
              s5_d, s5_w_glu, s5_b_glu, w_branch_a, w_branch_b, w_out,
              norm2_g, w_ffn_gate, w_ffn_up, w_ffn_down, norm_f_g):
    for l in range(DEPTH):
        x = hybrid_layer(x, norm1_g[l], w_in[l], gmlp_ln_g[l], gmlp_ln_b[l], gmlp_ws[l], gmlp_bs[l],
                         s5_lambda_re[l], s5_lambda_im[l], s5_log_dt[l], s5_b_re[l], s5_b_im[l],
                         s5_c_re[l], s5_c_im[l], s5_d[l], s5_w_glu[l], s5_b_glu[l],
                         w_branch_a[l], w_branch_b[l], w_out[l],
                         norm2_g[l], w_ffn_gate[l], w_ffn_up[l], w_ffn_down[l])
    return rms_norm(x, norm_f_g)
```

```cpp
#include <hip/hip_runtime.h>
#include <hip/hip_cooperative_groups.h>
#include <cstdio>
namespace cg = cooperative_groups;

#ifndef MK_PER_PHASE
#define MK_PER_PHASE 0
#endif

#ifndef MK_WGM_BIG
#define MK_WGM_BIG 4
#endif
#ifndef MK_REPEAT
#define MK_REPEAT -1
#endif
#define LAS __attribute__((address_space(3)))
typedef unsigned short bf16_t;
typedef short bf16x8 __attribute__((ext_vector_type(8)));
typedef float f32x4 __attribute__((ext_vector_type(4)));
typedef float f32x2 __attribute__((ext_vector_type(2)));
typedef unsigned u32x4 __attribute__((ext_vector_type(4)));
typedef unsigned u32x2 __attribute__((ext_vector_type(2)));

constexpr int T_TOK = 32768, DM = 1024, INW = 4608, FFH = 2816, S5W = 512, S5G = 32, S5P = 64, S5H = 16;
constexpr int TC = 32;
constexpr int NCHB = 8192 / TC;
constexpr int NCH = T_TOK / TC;
constexpr int XGW = TC * S5H + 2 * S5P;
constexpr float EPSV = 1e-6f;
constexpr int NTHR = 512;
constexpr int LDS_STAGE = 131072;
constexpr int LDS_RSTD = LDS_STAGE + 16;
constexpr int LDS_BYTES = LDS_RSTD + 12 * 256 * 4;

constexpr size_t MiB = 1048576;
constexpr size_t WS_R0 = 0 * MiB;
constexpr size_t WS_R1 = 64 * MiB;
constexpr size_t WS_R2 = 128 * MiB;
constexpr size_t WS_R3 = 192 * MiB;
constexpr size_t WS_R4 = 256 * MiB;
constexpr size_t WS_XGE = 320 * MiB;
constexpr size_t WS_TOEP = 360 * MiB;
constexpr size_t WS_M1 = 380 * MiB;
constexpr size_t WS_S = 385 * MiB;
constexpr size_t WS_WIN = 401 * MiB;
constexpr size_t WS_WGLU = 410 * MiB;
constexpr size_t WS_PA = 411 * MiB;
constexpr size_t WS_PB = 439 * MiB;
constexpr size_t WS_WOUT = 414 * MiB;
constexpr size_t WS_WGU = 416 * MiB;
constexpr size_t WS_WD = 427 * MiB;
constexpr size_t WS_VSTAT = 433 * MiB;
constexpr size_t WS_RS2P = 437 * MiB;
constexpr size_t WS_RSFP = 439 * MiB;
constexpr size_t WS_RSTD1 = 441 * MiB;
constexpr size_t WS_KTAB = 442 * MiB;
constexpr size_t WS_A32 = 443 * MiB;
constexpr size_t WS_WM = 444 * MiB;
constexpr size_t WS_BAR = 446 * MiB;
constexpr size_t WS_PCNT = WS_BAR + 16384;
constexpr size_t WS_XB = 447 * MiB;
constexpr size_t WS_END = 511 * MiB;

struct Params { const float* in[25]; float* out; unsigned char* ws; int ph_lo, ph_hi; };

typedef __bf16 bf16x2_t __attribute__((ext_vector_type(2)));
__device__ __forceinline__ unsigned cvt_pk_bf16(float lo, float hi) { const f32x2 f = {lo, hi}; const bf16x2_t b = __builtin_convertvector(f, bf16x2_t); return __builtin_bit_cast(unsigned, b); }
__device__ __forceinline__ float bf_lo(unsigned w) { return __uint_as_float(w << 16); }
__device__ __forceinline__ float bf_hi(unsigned w) { return __uint_as_float(w & 0xffff0000u); }
__device__ __forceinline__ float sigmoid_f(float x) { return __builtin_amdgcn_rcpf(1.0f + __builtin_amdgcn_exp2f(-1.442695041f * x)); }
__device__ __forceinline__ float gelu_t(float x) {
    const float z = x * (0.7978845608f + 0.0356774081f * x * x);
    return x * __builtin_amdgcn_rcpf(1.0f + __builtin_amdgcn_exp2f(-2.885390082f * z));
}
__device__ __forceinline__ float silu_f(float x) { return x * sigmoid_f(x); }
__device__ __forceinline__ f32x2 gelu2(f32x2 x) {
    const f32x2 t = x * ((x * x) * (-0.1029432397f) + (-2.302208198f));
    f32x2 e; e.x = __builtin_amdgcn_exp2f(t.x); e.y = __builtin_amdgcn_exp2f(t.y);
    const f32x2 d = e + 1.0f;
    f32x2 r; r.x = __builtin_amdgcn_rcpf(d.x); r.y = __builtin_amdgcn_rcpf(d.y);
    return x * r;
}
__device__ __forceinline__ void gelu8(float (&v)[8]) {
#pragma unroll
    for (int i = 0; i < 8; i += 2) { const f32x2 g = gelu2((f32x2){v[i], v[i + 1]}); v[i] = g.x; v[i + 1] = g.y; }
}
__device__ __forceinline__ u32x4 pack8(const float (&v)[8]) { u32x4 r; r[0] = cvt_pk_bf16(v[0], v[1]); r[1] = cvt_pk_bf16(v[2], v[3]); r[2] = cvt_pk_bf16(v[4], v[5]); r[3] = cvt_pk_bf16(v[6], v[7]); return r; }
__device__ __forceinline__ void unpack8(const u32x4 w, float (&v)[8]) {
#pragma unroll
    for (int i = 0; i < 4; ++i) { v[2 * i] = bf_lo(w[i]); v[2 * i + 1] = bf_hi(w[i]); }
}


#define XB_TMO      128
#define XB_XCNT(j)  (256  + 64 * (j))
#define XB_XSUB(j)  (1280 + 64 * (j))
#define XB_XGEN(j)  (2304 + 64 * (j))
#define XB_TOP      3328
#define XB_TOPGEN   3392
#define XCD_BAR_WORDS 3456
#define XB_SPIN_CAP (1u << 22)
__device__ __forceinline__ unsigned xb_ld(unsigned* p)              { return __hip_atomic_load(p, __ATOMIC_RELAXED, __HIP_MEMORY_SCOPE_AGENT); }
__device__ __forceinline__ unsigned xb_add(unsigned* p, unsigned v) { return __hip_atomic_fetch_add(p, v, __ATOMIC_RELAXED, __HIP_MEMORY_SCOPE_AGENT); }
__device__ __forceinline__ unsigned xb_xcc_id() { return (unsigned)__builtin_amdgcn_s_getreg((3 << 11) | 20) & 0xFu; }
#define XB_SPIN(cond, bar) do { unsigned _sp = 0; while (cond) { __builtin_amdgcn_s_sleep(1); \
    if ((++_sp & 255u) == 0u) { if (xb_ld(&(bar)[XB_TMO])) break; if (_sp > XB_SPIN_CAP) { atomicAdd(&(bar)[XB_TMO], 1u); break; } } } } while (0)
struct XcdBarrier { unsigned* bar; unsigned x; volatile LAS unsigned* st; };
__device__ __forceinline__ XcdBarrier xcd_barrier_post(unsigned* bar, volatile LAS unsigned* st) {
    XcdBarrier b; b.bar = bar; b.x = xb_xcc_id(); b.st = st;
    if (threadIdx.x == 0) (void)xb_add(&bar[XB_XCNT(b.x)], 1u);
    return b;
}
__device__ __forceinline__ void xcd_barrier_complete(unsigned* bar, unsigned x, unsigned& nloc, unsigned& nx) {
    const unsigned G = gridDim.x * gridDim.y * gridDim.z;
    unsigned sum, cnt, mine, sp = 0u;
    for (;;) {
        sum = 0u; cnt = 0u; mine = 0u;
#pragma unroll
        for (unsigned j = 0; j < 16; ++j) { const unsigned c = xb_ld(&bar[XB_XCNT(j)]); sum += c; cnt += (c > 0u) ? 1u : 0u; mine = (j == x) ? c : mine; }
        if (sum == G) break;
        __builtin_amdgcn_s_sleep(1);
        if ((++sp & 255u) == 0u) { if (xb_ld(&bar[XB_TMO])) break; if (sp > XB_SPIN_CAP) { atomicAdd(&bar[XB_TMO], 1u); break; } }
    }
    nloc = mine > 0u ? mine : 1u; nx = cnt > 0u ? cnt : 1u;
}
__device__ __forceinline__ void xcd_barrier(const XcdBarrier& b) {
    asm volatile("s_waitcnt vmcnt(0)" ::: "memory");
    __syncthreads();
    if (threadIdx.x == 0) {
        unsigned* bar = b.bar;
        __builtin_amdgcn_s_waitcnt(0);
        unsigned nloc = b.st[0], nx = b.st[1];
        if (nloc == 0u) { xcd_barrier_complete(bar, b.x, nloc, nx); b.st[0] = nloc; b.st[1] = nx; }
        const unsigned old = xb_add(&bar[XB_XSUB(b.x)], 1u);
        const unsigned gen = old / nloc;
        if (old + 1u == (gen + 1u) * nloc) {
            __builtin_amdgcn_fence(__ATOMIC_RELEASE, "agent");
            asm volatile("s_waitcnt vmcnt(0)" ::: "memory");
            const unsigned og = xb_add(&bar[XB_TOP], 1u);
            const unsigned tg = og / nx;
            if (og + 1u == (tg + 1u) * nx) xb_add(&bar[XB_TOPGEN], 1u);
            else XB_SPIN(xb_ld(&bar[XB_TOPGEN]) == tg, bar);
            __builtin_amdgcn_fence(__ATOMIC_ACQUIRE, "agent");
            xb_add(&bar[XB_XGEN(b.x)], 1u);
            asm volatile("s_waitcnt vmcnt(0)" ::: "memory");
        } else {
            XB_SPIN(xb_ld(&bar[XB_XGEN(b.x)]) == gen, bar);
            __builtin_amdgcn_fence(__ATOMIC_ACQUIRE, "agent");
            asm volatile("s_waitcnt vmcnt(0)" ::: "memory");
        }
    }
    __syncthreads();
}

namespace pg8 {
constexpr int BM = 256, BK = 64, HALF = 128, HTB = HALF * BK * 2, STAGE_BYTES = 8 * HTB, NXCD = 8, WGM = 8;
__host__ __device__ __forceinline__ int lds_byte(int r, int c) { const int st = (r >> 4) * 2 + (c >> 5), rr = r & 15, cc = c & 31, ob = rr * 64 + cc * 2; return st * 1024 + (ob ^ (((ob >> 9) & 1) << 5)); }
__host__ __device__ __forceinline__ void stage_rc(int b, int& R, int& C) { const int st = b / 1024, sb = b % 1024, swz = sb ^ (((sb >> 9) & 1) << 5); R = (st >> 1) * 16 + swz / 64; C = (st & 1) * 32 + (swz % 64) / 2; }
__host__ __device__ __forceinline__ int perm32(int rho) { const int n = rho >> 4, i = rho & 15; return 8 * (i >> 2) + 4 * n + (i & 3); }

struct Unit { int pm, pn, ra, rb, idx; const char* pa; const char* pb; int nt, kind; };
struct Gemm { const bf16_t* A; const bf16_t* Bt; int K, lda, ldb; };

struct StaticOrder {
    int nM, nN, nwg, G, c, wgm;
    __device__ void init(int M, int N, int G_, int c_, int wgm_ = WGM) { nM = M / BM; nN = N / BM; nwg = nM * nN; G = G_; c = c_; wgm = wgm_; }
    __device__ bool next(int i, Unit& u) const {
        const long L = (long)i * G + c; if (L >= nwg) return false;
        int wgid = (int)L; { const int q = nwg / NXCD, r = nwg % NXCD, xcd = wgid % NXCD, off = wgid / NXCD; wgid = (xcd < r ? xcd * (q + 1) : r * (q + 1) + (xcd - r) * q) + off; }
        const int nig = wgm * nN, gid = wgid / nig, fm = gid * wgm, gsz = (nM - fm) < wgm ? (nM - fm) : wgm;
        u.pm = fm + ((wgid % nig) % gsz); u.pn = (wgid % nig) / gsz; u.ra = u.pm * BM; u.rb = u.pn * BM; u.idx = i; return true;
    }
};
struct StateOrder {
    int G, c;
    __device__ bool next(int i, Unit& u) const { const int L = i * G + c; if (L >= 128) return false; u.pm = L; u.pn = 0; u.ra = L * BM; u.rb = (L >> 2) * 128; u.idx = i; return true; }
};
struct SegOrder {
    StaticOrder S; const char* a0; const char* b0; const char* a1; const char* b1; size_t pitch;
    __device__ bool next(int j, Unit& u) const {
        if (!S.next(j >> 1, u)) return false;
        u.idx = j; u.kind = j & 1; u.nt = (j & 1) ? 16 : 8;
        u.pa = ((j & 1) ? a1 : a0) + (size_t)u.ra * pitch; u.pb = ((j & 1) ? b1 : b0) + (size_t)u.rb * pitch; return true;
    }
};
struct OneStateUnit { int pm; __device__ bool next(int i, Unit& u) const { if (i > 0) return false; u.pm = pm; u.pn = 0; u.ra = pm * BM; u.rb = (pm >> 2) * 128; u.idx = 0; return true; } };
struct PanelPair { int pm; __device__ bool next(int i, Unit& u) const { if (i > 1) return false; u.pm = pm; u.pn = i; u.ra = pm * BM; u.rb = (pm >> 2) * 512 + i * BM; u.idx = i; return true; } };
struct S5OutOrder {
    int G, c;
    __device__ bool next(int i, Unit& u) const { const int L = i * G + c; if (L >= 256) return false; u.pm = L >> 1; u.pn = L & 1; u.ra = u.pm * BM; u.rb = (u.pm >> 2) * 512 + u.pn * BM; u.idx = i; return true; }
};

template <int KREP = 1, bool SEG = false, bool DRAIN_EPI = false, class Epi, class Sched>
__device__ __forceinline__ void gemm_phase(LAS unsigned char* lds, const Gemm g, const Sched& S, const Epi& E) {
    const int tid = threadIdx.x, wid = __builtin_amdgcn_readfirstlane(tid >> 6), lane = tid & 63, wr = wid >> 2, wc = wid & 3, fr = lane & 15, fq = lane >> 4;
    const int K = g.K, nt = K / BK;
    unsigned voffA[2], voffB[2];
#pragma unroll
    for (int i = 0; i < 2; ++i) { int R, C; stage_rc(tid * 16 + i * 8192, R, C); const int Rb = (R & ~31) + perm32(R & 31);
        voffA[i] = (unsigned)(R * g.lda + C) * 2u; voffB[i] = (unsigned)(Rb * g.ldb + C) * 2u; }
    const size_t kstep = (size_t)(BK * 2);
    const size_t hsA = (size_t)HALF * g.lda * 2, hsB = (size_t)HALF * g.ldb * 2;
    const size_t rowA = (size_t)g.lda * 2, rowB = (size_t)g.ldb * 2;
    const unsigned ldsw = (unsigned)wid * 1024u;
    const int aoff = lds_byte(wr * 64 + fr, fq * 8), boff = lds_byte(wc * 32 + fr, fq * 8);
#define PG8_SA(b, h) (((b) * 2 + (h)) * HTB)
#define PG8_SB(b, h) ((4 + (b) * 2 + (h)) * HTB)
#define PG8_STAGE(bufoff, gbase, voff) do { _Pragma("unroll") for (int _i = 0; _i < 2; ++_i) \
        __builtin_amdgcn_global_load_lds((const unsigned*)((const char*)(gbase) + (voff)[_i]), (LAS unsigned*)(lds + (bufoff) + ldsw + _i * 8192), 16, 0, 0); } while (0)
#define PG8_LDA(dst, b, h) do { _Pragma("unroll") for (int m = 0; m < 4; ++m) _Pragma("unroll") for (int k = 0; k < 2; ++k) dst[m][k] = *(const LAS bf16x8*)(lds + PG8_SA(b, h) + aoff + m * 2048 + k * 1024); } while (0)
#define PG8_LDB(dst, b, h) do { _Pragma("unroll") for (int n = 0; n < 2; ++n) _Pragma("unroll") for (int k = 0; k < 2; ++k) dst[n][k] = *(const LAS bf16x8*)(lds + PG8_SB(b, h) + boff + n * 2048 + k * 1024); } while (0)
#define PG8_MMA(ai, bj, At, Bt) do { __builtin_amdgcn_s_setprio(1); _Pragma("unroll") for (int m = 0; m < 4; ++m) _Pragma("unroll") for (int n = 0; n < 2; ++n) _Pragma("unroll") for (int k = 0; k < 2; ++k) \
        acc[ai][bj][m][n] = __builtin_amdgcn_mfma_f32_16x16x32_bf16(Bt[n][k], At[m][k], acc[ai][bj][m][n], 0, 0, 0); __builtin_amdgcn_s_setprio(0); } while (0)
#define PG8_WAIT_V(n) asm volatile("s_waitcnt vmcnt(" #n ")" ::: "memory")
#define PG8_WAIT_L(n) asm volatile("s_waitcnt lgkmcnt(" #n ")" ::: "memory")
#define PG8_BAR __builtin_amdgcn_s_barrier()
#define PG8_SCHED __builtin_amdgcn_sched_barrier(0)
    Unit cur, nxt; int ui = 0;
    if (!S.next(0, cur)) return;
    f32x4 acc[2][2][4][2];
#pragma unroll
    for (int a = 0; a < 2; ++a)
#pragma unroll
        for (int b = 0; b < 2; ++b)
#pragma unroll
            for (int m = 0; m < 4; ++m)
#pragma unroll
                for (int n = 0; n < 2; ++n) acc[a][b][m][n] = (f32x4){0.f, 0.f, 0.f, 0.f};
    bf16x8 At[4][2], B0[2][2], B1[2][2];
    const char* cA = SEG ? cur.pa : (const char*)g.A + (size_t)cur.ra * rowA; const char* cB = SEG ? cur.pb : (const char*)g.Bt + (size_t)cur.rb * rowB;
    PG8_STAGE(PG8_SB(0, 0), cB, voffB); PG8_STAGE(PG8_SA(0, 0), cA, voffA); PG8_STAGE(PG8_SB(0, 1), cB + hsB, voffB); PG8_STAGE(PG8_SA(0, 1), cA + hsA, voffA);
    if (wr == 1) PG8_BAR;
    PG8_WAIT_V(4); PG8_BAR;
    PG8_STAGE(PG8_SB(1, 0), cB + kstep, voffB); PG8_STAGE(PG8_SA(1, 0), cA + kstep, voffA); PG8_STAGE(PG8_SB(1, 1), cB + hsB + kstep, voffB);
    PG8_WAIT_V(6); PG8_BAR;
    for (;;) {
        const bool has_next = S.next(ui + 1, nxt);
        const char* nA = has_next ? (SEG ? nxt.pa : (const char*)g.A + (size_t)nxt.ra * rowA) : cA; const char* nB = has_next ? (SEG ? nxt.pb : (const char*)g.Bt + (size_t)nxt.rb * rowB) : cB;
        const int ntu = SEG ? cur.nt : nt;
        for (int kr = 0; kr < (KREP < 1 ? 1 : KREP); ++kr)
        for (int t = 0; t < ntu; t += 2) {
            const bool last = (t == ntu - 2);
            const char* a1 = cA + (size_t)(t + 1) * kstep;
            const char* a2 = last ? ((KREP > 1 && kr + 1 < KREP) ? cA : nA) : cA + (size_t)(t + 2) * kstep; const char* b2 = last ? ((KREP > 1 && kr + 1 < KREP) ? cB : nB) : cB + (size_t)(t + 2) * kstep;
            const char* a3 = a2 + kstep; const char* b3 = b2 + kstep;
            PG8_LDB(B0, 0, 0); PG8_SCHED; PG8_LDA(At, 0, 0); PG8_STAGE(PG8_SA(1, 1), a1 + hsA, voffA);
            PG8_WAIT_L(8); PG8_BAR; PG8_WAIT_L(0); PG8_MMA(0, 0, At, B0); PG8_BAR; PG8_SCHED;
            PG8_LDB(B1, 0, 1); PG8_STAGE(PG8_SB(0, 0), b2, voffB);
            PG8_BAR; PG8_WAIT_L(0); PG8_MMA(0, 1, At, B1); PG8_BAR;
            PG8_LDA(At, 0, 1); PG8_STAGE(PG8_SA(0, 0), a2, voffA);
            PG8_BAR; PG8_WAIT_L(0); PG8_MMA(1, 0, At, B0); PG8_BAR; PG8_SCHED;
            PG8_STAGE(PG8_SB(0, 1), b2 + hsB, voffB);
            PG8_WAIT_V(6); PG8_BAR; PG8_MMA(1, 1, At, B1); PG8_BAR;
            PG8_LDB(B0, 1, 0); PG8_SCHED; PG8_LDA(At, 1, 0); PG8_STAGE(PG8_SA(0, 1), a2 + hsA, voffA);
            PG8_WAIT_L(8); PG8_BAR; PG8_WAIT_L(0); PG8_MMA(0, 0, At, B0); PG8_BAR; PG8_SCHED;
            PG8_LDB(B1, 1, 1); PG8_STAGE(PG8_SB(1, 0), b3, voffB);
            PG8_BAR; PG8_WAIT_L(0); PG8_MMA(0, 1, At, B1); PG8_BAR;
            PG8_LDA(At, 1, 1); PG8_STAGE(PG8_SA(1, 0), a3, voffA);
            PG8_BAR; PG8_WAIT_L(0); PG8_MMA(1, 0, At, B0); PG8_BAR; PG8_SCHED;
            PG8_STAGE(PG8_SB(1, 1), b3 + hsB, voffB);
            PG8_WAIT_V(6); PG8_BAR; PG8_MMA(1, 1, At, B1); PG8_BAR;
        }
        asm volatile("" ::: "memory");
        if (wr == 0) PG8_BAR;
        asm volatile("" ::: "memory");
        if (!DRAIN_EPI) E(acc, cur, wr, wc, fr, fq);
        if (KREP < 0) { asm volatile("" ::: "memory"); E(acc, cur, wr, wc, fr, fq); }
        if (!has_next) break;
        if (!(SEG && cur.kind == 0)) {
#pragma unroll
        for (int a = 0; a < 2; ++a)
#pragma unroll
            for (int b = 0; b < 2; ++b)
#pragma unroll
                for (int m = 0; m < 4; ++m)
#pragma unroll
                    for (int n = 0; n < 2; ++n) acc[a][b][m][n] = (f32x4){0.f, 0.f, 0.f, 0.f};
        }
        cur = nxt; cA = nA; cB = nB; ++ui;
        asm volatile("" ::: "memory");
        if (wr == 1) PG8_BAR;
        asm volatile("" ::: "memory");
    }
    PG8_WAIT_V(0);
    PG8_BAR;
    if (DRAIN_EPI) { asm volatile("" ::: "memory"); E(acc, cur, wr, wc, fr, fq); }
#undef PG8_SA
#undef PG8_SB
#undef PG8_STAGE
#undef PG8_LDA
#undef PG8_LDB
#undef PG8_MMA
#undef PG8_WAIT_V
#undef PG8_WAIT_L
#undef PG8_BAR
#undef PG8_SCHED
}
}

typedef f32x4 AccT[2][2][4][2];
#define EPI_ROWS(u) for (int ai = 0; ai < 2; ++ai) for (int m = 0; m < 4; ++m)
#define EPI_LOAD8(v, ai, bj, m) do { _Pragma("unroll") for (int _q = 0; _q < 4; ++_q) { v[_q] = acc[ai][bj][m][0][_q]; v[4 + _q] = acc[ai][bj][m][1][_q]; } } while (0)

struct EpiProj {
    const float* rstd1; bf16_t* U; bf16_t* V; float* VSTAT; bf16_t* XGE; bf16_t* GA; bf16_t* GB;
    template <int KIND> __device__ __forceinline__ void seg(const AccT& acc, const pg8::Unit& u, int wr, int wc, int fr, int fq) const {
        const int row0 = u.pm * 256 + wr * 64 + fr, colb = u.pn * 256 + wc * 32 + 8 * fq;
        bf16_t* const gdst = (u.pn < 14) ? GA : GB; const int gofs = (u.pn < 14) ? 2560 : 3584;
#pragma unroll
        for (int ai = 0; ai < 2; ++ai) {
#pragma unroll
            for (int m = 0; m < 4; ++m) {
                const int row = row0 + ai * 128 + m * 16;
                float s = 0.f, q = 0.f;
#pragma unroll
                for (int bj = 0; bj < 2; ++bj) {
                    const int col = colb + bj * 128; float v[8]; EPI_LOAD8(v, ai, bj, m);
                    if (KIND == 0) {
                        *(u32x4*)(U + (size_t)row * DM + col) = pack8(v);
                    } else if (KIND == 1) {
                        gelu8(v);
#pragma unroll
                        for (int i = 0; i < 8; ++i) { s += v[i]; q += v[i] * v[i]; }
                        *(u32x4*)(V + (size_t)row * DM + (col - 1024)) = pack8(v);
                    } else if (KIND == 2) {
                        const int cl = col - 2048, gg = cl >> 4, hi0 = cl & 15;
                        *(u32x4*)(XGE + ((size_t)gg * NCH + (row >> 5)) * XGW + (row & 31) * 16 + hi0) = pack8(v);
                    } else if (bj == 0) {
                        float w[8]; EPI_LOAD8(w, ai, 1, m);
                        const int oc = (u.pn - 10) * 128 + wc * 32 + 8 * fq;
#pragma unroll
                        for (int i = 0; i < 8; ++i) { const float ea = fminf(__builtin_amdgcn_exp2f(-1.442695041f * v[i]), 1e30f), eb = fminf(__builtin_amdgcn_exp2f(-1.442695041f * w[i]), 1e30f);
                            v[i] = __builtin_amdgcn_rcpf(1.0f + ea); w[i] = (1.0f + ea) * __builtin_amdgcn_rcpf(1.0f + eb); }
                        *(u32x4*)(GA + (size_t)row * DM + oc) = pack8(v);
                        *(u32x4*)(GB + (size_t)row * DM + oc) = pack8(w);
                    }
                }
                if (KIND == 1) {
                    s += __shfl_xor(s, 16); q += __shfl_xor(q, 16); s += __shfl_xor(s, 32); q += __shfl_xor(q, 32);
                    if (fq == 0) *(f32x2*)(VSTAT + ((size_t)row * 16 + (u.pn - 4) * 4 + wc) * 2) = (f32x2){s, q};
                }
            }
        }
    }
    __device__ __forceinline__ void operator()(const AccT& acc, const pg8::Unit& u, int wr, int wc, int fr, int fq) const {
        if (u.pn < 4) seg<0>(acc, u, wr, wc, fr, fq);
        else if (u.pn < 8) seg<1>(acc, u, wr, wc, fr, fq);
        else if (u.pn < 10) seg<2>(acc, u, wr, wc, fr, fq);
        else seg<3>(acc, u, wr, wc, fr, fq);
    }
};
struct EpiState {
    float* S;
    __device__ __forceinline__ void operator()(const AccT& acc, const pg8::Unit& u, int wr, int wc, int fr, int fq) const {
        const int row0 = u.pm * 256 + wr * 64 + fr, col = wc * 32 + 8 * fq;
#pragma unroll
        for (int ai = 0; ai < 2; ++ai)
#pragma unroll
            for (int m = 0; m < 4; ++m) { float* p = S + (size_t)(row0 + ai * 128 + m * 16) * 128 + col; *(f32x4*)p = acc[ai][0][m][0]; *(f32x4*)(p + 4) = acc[ai][0][m][1]; }
    }
};
struct EpiStateLds {
    LAS float* L;
    __device__ __forceinline__ void operator()(const AccT& acc, const pg8::Unit& u, int wr, int wc, int fr, int fq) const {
        const int r0 = wr * 64 + fr, col = wc * 32 + 8 * fq;
#pragma unroll
        for (int ai = 0; ai < 2; ++ai)
#pragma unroll
            for (int m = 0; m < 4; ++m) { LAS float* q = L + (r0 + ai * 128 + m * 16) * 128 + col; *(LAS f32x4*)q = acc[ai][0][m][0]; *(LAS f32x4*)(q + 4) = acc[ai][0][m][1]; }
    }
};
struct EpiS5Out {
    bf16_t* YB0;
    __device__ __forceinline__ void operator()(const AccT& acc, const pg8::Unit& u, int wr, int wc, int fr, int fq) const {
        const int row0 = u.pm * 256 + wr * 64 + fr, colb = u.pn * 256 + wc * 32 + 8 * fq;
#pragma unroll
        for (int ai = 0; ai < 2; ++ai)
#pragma unroll
            for (int m = 0; m < 4; ++m) {
                const int row = row0 + ai * 128 + m * 16, gg = row >> 10, n = row & 1023;
#pragma unroll
                for (int bj = 0; bj < 2; ++bj) {
                    const int col = colb + bj * 128, t = col >> 4, ho0 = col & 15; float v[8]; EPI_LOAD8(v, ai, bj, m);
                    gelu8(v);
                    *(u32x4*)(YB0 + (size_t)(n * TC + t) * S5W + gg * 16 + ho0) = pack8(v);
                }
            }
    }
};
struct EpiGlu {
    const bf16_t* YB0; bf16_t* YB; const float* bias; int ldy;
    __device__ __forceinline__ void operator()(const AccT& acc, const pg8::Unit& u, int wr, int wc, int fr, int fq) const {
        const int row0 = u.pm * 256 + wr * 64 + fr, colb = u.pn * 256 + wc * 32 + 8 * fq;
        f32x4 bq[2][2];
#pragma unroll
        for (int bj = 0; bj < 2; ++bj) { bq[bj][0] = *(const f32x4*)(bias + colb + bj * 128); bq[bj][1] = *(const f32x4*)(bias + colb + bj * 128 + 4); }
#pragma unroll
        for (int ai = 0; ai < 2; ++ai)
#pragma unroll
            for (int mp = 0; mp < 1; ++mp) {
                u32x4 yv[4][2];
#pragma unroll
                for (int mm = 0; mm < 4; ++mm)
#pragma unroll
                    for (int bj = 0; bj < 2; ++bj) yv[mm][bj] = *(const u32x4*)(YB0 + (size_t)(row0 + ai * 128 + mm * 16) * S5W + colb + bj * 128);
#pragma unroll
                for (int mm = 0; mm < 4; ++mm)
#pragma unroll
                    for (int bj = 0; bj < 2; ++bj) { const int m = mm;
                        float v[8], y[8]; EPI_LOAD8(v, ai, bj, m); unpack8(yv[mm][bj], y);
#pragma unroll
                        for (int i = 0; i < 8; ++i) v[i] = y[i] * sigmoid_f(v[i] + (i < 4 ? bq[bj][0][i & 3] : bq[bj][1][i & 3]));
                        *(u32x4*)(YB + (size_t)(row0 + ai * 128 + m * 16) * ldy + colb + bj * 128) = pack8(v); }
            }
    }
};
template <int ACCUM> struct EpiMerge {
    const bf16_t* GATE; bf16_t* MRG;
    __device__ __forceinline__ void operator()(const AccT& acc, const pg8::Unit& u, int wr, int wc, int fr, int fq) const {
        const int row0 = u.pm * 256 + wr * 64 + fr, colb = u.pn * 256 + wc * 32 + 8 * fq;
        constexpr int NB = ACCUM ? 2 : 4;
#pragma unroll
        for (int ai = 0; ai < 2; ++ai)
#pragma unroll
            for (int mb = 0; mb < 4; mb += NB) {
                u32x4 gv[NB][2], ov[NB][2];
#pragma unroll
                for (int mm = 0; mm < NB; ++mm)
#pragma unroll
                    for (int bj = 0; bj < 2; ++bj) { const size_t off = (size_t)(row0 + ai * 128 + (mb + mm) * 16) * DM + colb + bj * 128;
                        gv[mm][bj] = *(const u32x4*)(GATE + off); if (ACCUM) ov[mm][bj] = *(const u32x4*)(MRG + off); }
#pragma unroll
                for (int mm = 0; mm < NB; ++mm)
#pragma unroll
                    for (int bj = 0; bj < 2; ++bj) { const int m = mb + mm; const size_t off = (size_t)(row0 + ai * 128 + m * 16) * DM + colb + bj * 128;
                        float v[8], g[8]; EPI_LOAD8(v, ai, bj, m); unpack8(gv[mm][bj], g);
                        if (ACCUM) { float o[8]; unpack8(ov[mm][bj], o);
#pragma unroll
                            for (int i = 0; i < 8; ++i) v[i] = o[i] + g[i] * v[i]; }
                        else {
#pragma unroll
                            for (int i = 0; i < 8; ++i) v[i] = g[i] * v[i]; }
                        *(u32x4*)(MRG + off) = pack8(v); }
            }
    }
};
struct EpiMergeSeg {
    const bf16_t* GA; const bf16_t* GB; bf16_t* MRG;
    __device__ __forceinline__ void operator()(AccT& acc, const pg8::Unit& u, int wr, int wc, int fr, int fq) const {
        const int row0 = u.pm * 256 + wr * 64 + fr, colb = u.pn * 256 + wc * 32 + 8 * fq;
        if (u.kind == 0) {
#pragma unroll
            for (int ai = 0; ai < 2; ++ai) {
                u32x4 bv[4][2];
#pragma unroll
                for (int m = 0; m < 4; ++m)
#pragma unroll
                    for (int bj = 0; bj < 2; ++bj) bv[m][bj] = *(const u32x4*)(GB + (size_t)(row0 + ai * 128 + m * 16) * DM + colb + bj * 128);
#pragma unroll
                for (int m = 0; m < 4; ++m)
#pragma unroll
                    for (int bj = 0; bj < 2; ++bj) { float b[8]; unpack8(bv[m][bj], b);
                        acc[ai][bj][m][0] *= (f32x4){b[0], b[1], b[2], b[3]}; acc[ai][bj][m][1] *= (f32x4){b[4], b[5], b[6], b[7]}; }
            }
        } else {
#pragma unroll
            for (int ai = 0; ai < 2; ++ai) {
                u32x4 av[4][2];
#pragma unroll
                for (int m = 0; m < 4; ++m)
#pragma unroll
                    for (int bj = 0; bj < 2; ++bj) av[m][bj] = *(const u32x4*)(GA + (size_t)(row0 + ai * 128 + m * 16) * DM + colb + bj * 128);
#pragma unroll
                for (int m = 0; m < 4; ++m)
#pragma unroll
                    for (int bj = 0; bj < 2; ++bj) { float v[8], a[8]; EPI_LOAD8(v, ai, bj, m); unpack8(av[m][bj], a);
#pragma unroll
                        for (int i = 0; i < 8; ++i) v[i] *= a[i];
                        *(u32x4*)(MRG + (size_t)(row0 + ai * 128 + m * 16) * DM + colb + bj * 128) = pack8(v); }
            }
        }
    }
};
template <int RES_BF> struct EpiResid {
    const void* RES; bf16_t* XBF; float* PART; const float* RSC;
    __device__ __forceinline__ void operator()(const AccT& acc, const pg8::Unit& u, int wr, int wc, int fr, int fq) const {
        const int row0 = u.pm * 256 + wr * 64 + fr, colb = u.pn * 256 + wc * 32 + 8 * fq;
        constexpr int NB = RES_BF ? 4 : 2;
        constexpr bool SCALED = (RES_BF == 2);
#pragma unroll
        for (int ai = 0; ai < 2; ++ai)
#pragma unroll
            for (int mb = 0; mb < 4; mb += NB) {
                f32x4 rf[NB][2][2]; u32x4 rb[NB][2]; float rsc[NB];
#pragma unroll
                for (int mm = 0; mm < NB; ++mm) rsc[mm] = SCALED ? RSC[row0 + ai * 128 + (mb + mm) * 16] : 1.0f;
#pragma unroll
                for (int mm = 0; mm < NB; ++mm)
#pragma unroll
                    for (int bj = 0; bj < 2; ++bj) { const size_t off = (size_t)(row0 + ai * 128 + (mb + mm) * 16) * DM + colb + bj * 128;
                        if (RES_BF) rb[mm][bj] = *(const u32x4*)((const bf16_t*)RES + off);
                        else { rf[mm][bj][0] = *(const f32x4*)((const float*)RES + off); rf[mm][bj][1] = *(const f32x4*)((const float*)RES + off + 4); } }
#pragma unroll
                for (int mm = 0; mm < NB; ++mm) {
                    const int m = mb + mm, row = row0 + ai * 128 + m * 16; float q = 0.f;
#pragma unroll
                    for (int bj = 0; bj < 2; ++bj) {
                        const size_t off = (size_t)row * DM + colb + bj * 128;
                        float v[8], r[8]; EPI_LOAD8(v, ai, bj, m);
                        if (RES_BF) unpack8(rb[mm][bj], r);
                        else {
#pragma unroll
                            for (int i = 0; i < 4; ++i) { r[i] = rf[mm][bj][0][i]; r[4 + i] = rf[mm][bj][1][i]; } }
#pragma unroll
                        for (int i = 0; i < 8; ++i) { v[i] += SCALED ? r[i] * rsc[mm] : r[i]; q += v[i] * v[i]; }
                        *(u32x4*)(XBF + off) = pack8(v);
                    }
                    q += __shfl_xor(q, 16); q += __shfl_xor(q, 32);
                    if (fq == 0) PART[(size_t)row * 16 + u.pn * 4 + wc] = q;
                }
            }
    }
};
struct EpiFinal {
    const bf16_t* RES; float* OUT; float* PART; unsigned* CNT; const float* gf;
    __device__ __forceinline__ void operator()(const AccT& acc, const pg8::Unit& u, int wr, int wc, int fr, int fq) const {
        const int row0 = u.pm * 256 + wr * 64 + fr, colb = u.pn * 256 + wc * 32 + 8 * fq;
        f32x4 xv[2][2][4][2];
#pragma unroll
        for (int ai = 0; ai < 2; ++ai) {
            u32x4 rb[4][2];
#pragma unroll
            for (int m = 0; m < 4; ++m)
#pragma unroll
                for (int bj = 0; bj < 2; ++bj) rb[m][bj] = *(const u32x4*)(RES + (size_t)(row0 + ai * 128 + m * 16) * DM + colb + bj * 128);
#pragma unroll
            for (int m = 0; m < 4; ++m) {
                const int row = row0 + ai * 128 + m * 16; float q = 0.f;
#pragma unroll
                for (int bj = 0; bj < 2; ++bj) {
                    float v[8], r[8]; EPI_LOAD8(v, ai, bj, m); unpack8(rb[m][bj], r);
#pragma unroll
                    for (int i = 0; i < 8; ++i) { v[i] += r[i]; q += v[i] * v[i]; }
                    xv[ai][bj][m][0] = (f32x4){v[0], v[1], v[2], v[3]}; xv[ai][bj][m][1] = (f32x4){v[4], v[5], v[6], v[7]};
                }
                q += __shfl_xor(q, 16); q += __shfl_xor(q, 32);
                if (fq == 0) __hip_atomic_store(PART + (size_t)row * 16 + u.pn * 4 + wc, q, __ATOMIC_RELAXED, __HIP_MEMORY_SCOPE_AGENT);
            }
        }
        asm volatile("s_waitcnt vmcnt(0)" ::: "memory");
        __builtin_amdgcn_s_barrier();
        if (threadIdx.x == 0) {
            unsigned* cnt = CNT + 64 * u.pm;
            __hip_atomic_fetch_add(cnt, 1u, __ATOMIC_RELAXED, __HIP_MEMORY_SCOPE_AGENT);
            unsigned sp = 0;
            while (__hip_atomic_load(cnt, __ATOMIC_RELAXED, __HIP_MEMORY_SCOPE_AGENT) < 4u) { __builtin_amdgcn_s_sleep(1); if (++sp > (1u << 22)) break; }
            __builtin_amdgcn_fence(__ATOMIC_ACQUIRE, "agent");
            asm volatile("s_waitcnt vmcnt(0)" ::: "memory");
        }
        asm volatile("" ::: "memory");
        __builtin_amdgcn_s_barrier();
        asm volatile("" ::: "memory");
#pragma unroll
        for (int ai = 0; ai < 2; ++ai) {
            f32x4 pv[4];
#pragma unroll
            for (int m = 0; m < 4; ++m) pv[m] = *(const f32x4*)(PART + (size_t)(row0 + ai * 128 + m * 16) * 16 + 4 * fq);
            f32x4 gq[2][2];
#pragma unroll
            for (int bj = 0; bj < 2; ++bj) { gq[bj][0] = *(const f32x4*)(gf + colb + bj * 128); gq[bj][1] = *(const f32x4*)(gf + colb + bj * 128 + 4); }
#pragma unroll
            for (int m = 0; m < 4; ++m) {
                float ss = (pv[m][0] + pv[m][1]) + (pv[m][2] + pv[m][3]); ss += __shfl_xor(ss, 16); ss += __shfl_xor(ss, 32);
                const float rs = 1.0f / sqrtf(ss * (1.0f / DM) + EPSV);
#pragma unroll
                for (int bj = 0; bj < 2; ++bj) {
                    float* o = OUT + (size_t)(row0 + ai * 128 + m * 16) * DM + colb + bj * 128;
                    *(f32x4*)o = xv[ai][bj][m][0] * rs * gq[bj][0]; *(f32x4*)(o + 4) = xv[ai][bj][m][1] * rs * gq[bj][1];
                }
            }
        }
    }
};
struct EpiGateUp {
    const LAS float* RSL; bf16_t* ACT;
    __device__ __forceinline__ void operator()(const AccT& acc, const pg8::Unit& u, int wr, int wc, int fr, int fq) const {
        const int row0 = u.pm * 256 + wr * 64 + fr, colb = (u.pn * 256 + wc * 32 + 8 * fq) >> 1;
        float rs8[2][4];
#pragma unroll
        for (int ai = 0; ai < 2; ++ai)
#pragma unroll
            for (int m = 0; m < 4; ++m) rs8[ai][m] = RSL[u.idx * 256 + ai * 128 + wr * 64 + m * 16 + fr] * ((MK_REPEAT) == 20 ? 0.5f : 1.0f);
#pragma unroll
        for (int ai = 0; ai < 2; ++ai)
#pragma unroll
            for (int m = 0; m < 4; ++m) {
                const int row = row0 + ai * 128 + m * 16; const float rs = rs8[ai][m];
#pragma unroll
                for (int bj = 0; bj < 2; ++bj) {
                    const f32x4 gt = acc[ai][bj][m][0], up = acc[ai][bj][m][1]; float o[4];
                    const float rsl = rs * (-1.442695041f), rs2 = rs * rs;
#pragma unroll
                    for (int i = 0; i < 4; i += 2) {
                        const f32x2 g2 = {gt[i], gt[i + 1]}, u2 = {up[i], up[i + 1]};
                        const f32x2 t = g2 * rsl; f32x2 e; e.x = __builtin_amdgcn_exp2f(t.x); e.y = __builtin_amdgcn_exp2f(t.y);
                        const f32x2 d = e + 1.0f; f32x2 r; r.x = __builtin_amdgcn_rcpf(d.x); r.y = __builtin_amdgcn_rcpf(d.y);
                        const f32x2 w = ((g2 * u2) * r) * rs2; o[i] = w.x; o[i + 1] = w.y;
                    }
                    *(u32x2*)(ACT + (size_t)row * FFH + colb + bj * 64) = (u32x2){cvt_pk_bf16(o[0], o[1]), cvt_pk_bf16(o[2], o[3])};
                }
            }
    }
};

struct Ctx { LAS unsigned char* lds; int tid, lane, wave, G, bx; };

__device__ __forceinline__ void p0_convert_x(const Ctx& c, const float* x, bf16_t* XB, float* rstd1) {
    for (int base = c.bx * 128; base < T_TOK; base += c.G * 128) {
        for (int rr = 0; rr < 16; rr += 4) {
            const int row0 = base + c.wave * 16 + rr;
            f32x4 v[4][4];
#pragma unroll
            for (int r = 0; r < 4; ++r)
#pragma unroll
                for (int j = 0; j < 4; ++j) v[r][j] = __builtin_nontemporal_load((const f32x4*)(x + (size_t)(row0 + r) * DM + j * 256 + c.lane * 4));
#pragma unroll
            for (int r = 0; r < 4; ++r) {
                float q = 0.f;
#pragma unroll
                for (int j = 0; j < 4; ++j) q += v[r][j][0] * v[r][j][0] + v[r][j][1] * v[r][j][1] + v[r][j][2] * v[r][j][2] + v[r][j][3] * v[r][j][3];
#pragma unroll
                for (int o = 32; o >= 1; o >>= 1) q += __shfl_xor(q, o);
                const float rms = sqrtf(q * (1.0f / DM) + EPSV), rs = 1.0f / rms;
                if (c.lane == 0) rstd1[row0 + r] = rms;
#pragma unroll
                for (int j = 0; j < 4; ++j) *(u32x2*)(XB + (size_t)(row0 + r) * DM + j * 256 + c.lane * 4) = (u32x2){cvt_pk_bf16(v[r][j][0] * rs, v[r][j][1] * rs), cvt_pk_bf16(v[r][j][2] * rs, v[r][j][3] * rs)};
            }
        }
    }
}
__device__ __forceinline__ void transpose_quad(const Ctx& c, const float* W, int K, int N, const float* gs, bf16_t* Wt, int ldw, int map, int tk4, int tn) {
    LAS float* tile = (LAS float*)c.lds;
    const int k0 = tk4 * 256, n0 = tn * 64, nn = c.tid & 63, kq = c.tid >> 6;
    float v[32];
#pragma unroll
    for (int e = 0; e < 32; ++e) v[e] = W[(size_t)(k0 + kq + 8 * e) * N + n0 + nn];
    if (gs) {
#pragma unroll
        for (int e = 0; e < 32; ++e) v[e] *= gs[k0 + kq + 8 * e];
    }
#pragma unroll
    for (int e = 0; e < 32; ++e) tile[(kq + 8 * e) * 65 + nn] = v[e];
    __syncthreads();
    { const int ks = kq * 32; const int n = n0 + nn; const int dn = map == 0 ? n : (map == 3 ? (n < 2560 ? n : (n < 3584 ? 2560 + 256 * ((n - 2560) >> 7) + ((n - 2560) & 127) : 2560 + 256 * ((n - 3584) >> 7) + 128 + ((n - 3584) & 127))) : (8 * (n >> 2) + (n & 3) + (map == 2 ? 4 : 0)));
        bf16_t* dst = Wt + (size_t)dn * ldw + k0 + ks;
#pragma unroll
        for (int q = 0; q < 4; ++q) { float f[8];
#pragma unroll
            for (int j = 0; j < 8; ++j) f[j] = tile[(ks + q * 8 + j) * 65 + nn];
            *(u32x4*)(dst + q * 8) = pack8(f); } }
    __syncthreads();
}
__device__ __forceinline__ void p0_weights(const Ctx& c, const Params& p, int j0, int j1, int first, int nblk) {
    unsigned char* ws = p.ws;
    if (c.bx < first || c.bx >= first + nblk) return;
    for (int job = j0 + (c.bx - first); job < j1; job += nblk) {
        const float* W; int K, N, map = 0, t = job, ldw = 0; const float* gs = nullptr; bf16_t* Wt;
        if (job < 288) { W = p.in[2]; K = 1024; N = 4608; gs = p.in[1]; Wt = (bf16_t*)(ws + WS_WIN); map = 3; }
        else if (job < 304) { t = job - 288; W = p.in[15]; K = 512; N = 512; Wt = (bf16_t*)(ws + WS_WGLU); }
        else if (job < 368) { t = job - 304; W = p.in[17]; K = 1024; N = 1024; Wt = (bf16_t*)(ws + WS_PA); }
        else if (job < 400) { t = job - 368; W = p.in[18]; K = 512; N = 1024; Wt = (bf16_t*)(ws + WS_PB); ldw = 1024; }
        else if (job < 464) { t = job - 400; W = p.in[19]; K = 1024; N = 1024; Wt = (bf16_t*)(ws + WS_WOUT); }
        else if (job < 640) { t = job - 464; W = p.in[21]; K = 1024; N = 2816; gs = p.in[20]; Wt = (bf16_t*)(ws + WS_WGU); map = 1; }
        else if (job < 816) { t = job - 640; W = p.in[22]; K = 1024; N = 2816; gs = p.in[20]; Wt = (bf16_t*)(ws + WS_WGU); map = 2; }
        else { t = job - 816; W = p.in[23]; K = 2816; N = 1024; Wt = (bf16_t*)(ws + WS_WD); }
        const int nk = K / 256;
        transpose_quad(c, W, K, N, gs, Wt, ldw ? ldw : K, map, t % nk, t / nk);
    }
}
__device__ __forceinline__ void p0_s5_tables(const Ctx& c, const Params& p) {
    LAS float* AP = (LAS float*)c.lds;
    LAS float* BB = AP + 33 * 64 * 2;
    LAS float* CC = BB + 64 * 16 * 2;
    LAS float* DD = CC + 16 * 64 * 2;
    unsigned char* ws = p.ws;
    float* KTAB = (float*)(ws + WS_KTAB); bf16_t* M1 = (bf16_t*)(ws + WS_M1); bf16_t* TOEP = (bf16_t*)(ws + WS_TOEP); float* A32 = (float*)(ws + WS_A32);
    for (int item = c.bx; item < 256; item += c.G) {
        const int g = item >> 3, r = item & 7;
        __syncthreads();
        if (c.tid < 64) {
            const int pi = c.tid;
            const float dt = expf(p.in[9][g]), lr = p.in[7][g * 64 + pi], li = p.in[8][g * 64 + pi];
            const float mag = expf(lr * dt), are = mag * cosf(li * dt), aim = mag * sinf(li * dt);
            const float den = lr * lr + li * li, nr = are - 1.0f;
            const float cre = (nr * lr + aim * li) / den, cim = (aim * lr - nr * li) / den;
            for (int h = 0; h < 16; ++h) { const float br = p.in[10][(g * 64 + pi) * 16 + h], bi = p.in[11][(g * 64 + pi) * 16 + h];
                BB[(pi * 16 + h) * 2] = cre * br - cim * bi; BB[(pi * 16 + h) * 2 + 1] = cre * bi + cim * br; }
            float pr = 1.f, pim = 0.f;
            for (int k = 0; k <= 32; ++k) { AP[(k * 64 + pi) * 2] = pr; AP[(k * 64 + pi) * 2 + 1] = pim; const float t0 = pr * are - pim * aim, t1 = pr * aim + pim * are; pr = t0; pim = t1; }
        }
        for (int e = c.tid; e < 1024; e += NTHR) { const int h = e >> 6, pi = e & 63; CC[e * 2] = p.in[12][(g * 16 + h) * 64 + pi]; CC[e * 2 + 1] = p.in[13][(g * 16 + h) * 64 + pi]; }
        if (c.tid < 16) DD[c.tid] = p.in[14][g * 16 + c.tid];
        __syncthreads();
        if (r == 0 && c.tid < 64) { A32[(g * 64 + c.tid) * 2] = AP[(32 * 64 + c.tid) * 2]; A32[(g * 64 + c.tid) * 2 + 1] = AP[(32 * 64 + c.tid) * 2 + 1]; }
        for (int e = c.tid; e < 1024; e += NTHR) {
            const int lag = 4 * r + (e >> 8), ho = (e >> 4) & 15, hi = e & 15; float s = 0.f;
            for (int pi = 0; pi < 64; ++pi) {
                const float ar = AP[(lag * 64 + pi) * 2], ai = AP[(lag * 64 + pi) * 2 + 1], br = BB[(pi * 16 + hi) * 2], bi = BB[(pi * 16 + hi) * 2 + 1];
                const float wre = ar * br - ai * bi, wim = ar * bi + ai * br;
                s += CC[(ho * 64 + pi) * 2] * wre - CC[(ho * 64 + pi) * 2 + 1] * wim;
            }
            if (lag == 0 && ho == hi) s += DD[ho];
            KTAB[(size_t)(g * 32 + lag) * 256 + ho * 16 + hi] = s;
        }
        for (int e = c.tid; e < 8192; e += NTHR) {
            const int row = 16 * r + (e >> 9), k = e & 511, pi = row & 63, s = k >> 4, hi = k & 15;
            const float ar = AP[((31 - s) * 64 + pi) * 2], ai = AP[((31 - s) * 64 + pi) * 2 + 1], br = BB[(pi * 16 + hi) * 2], bi = BB[(pi * 16 + hi) * 2 + 1];
            const float v = (row < 64) ? (ar * br - ai * bi) : (ar * bi + ai * br);
            M1[((size_t)g * 128 + row) * 512 + k] = (bf16_t)(cvt_pk_bf16(v, 0.f) & 0xffffu);
        }
        for (int e = c.tid; e < 8192; e += NTHR) {
            const int rl = e >> 7, q = e & 127, t = 4 * r + (rl >> 4), ho = rl & 15, pi = q & 63;
            const float ar = AP[((t + 1) * 64 + pi) * 2], ai = AP[((t + 1) * 64 + pi) * 2 + 1], cr = CC[(ho * 64 + pi) * 2], ci = CC[(ho * 64 + pi) * 2 + 1];
            const float v = (q < 64) ? (cr * ar - ci * ai) : -(cr * ai + ci * ar);
            TOEP[((size_t)g * 512 + t * 16 + ho) * XGW + 512 + q] = (bf16_t)(cvt_pk_bf16(v, 0.f) & 0xffffu);
        }
    }
    __syncthreads();
}
__device__ __forceinline__ void p0_wm(const Ctx& c, const float* wsp, bf16_t* WM) {
    for (int e = c.bx * NTHR + c.tid; e < 8 * 128 * 128; e += c.G * NTHR) {
        const int i = (e >> 7) & 127, j = e & 127; const float v = ((j >> 6) <= (i >> 6)) ? wsp[e] : 0.f;
        WM[e] = (bf16_t)(cvt_pk_bf16(v, 0.f) & 0xffffu);
    }
}
__device__ __forceinline__ void p2_gmlp_mix(const Ctx& c, const Params& p, int nb0, int nbstride) {
    unsigned char* ws = p.ws;
    const bf16_t* U = (const bf16_t*)(ws + WS_R1); const bf16_t* V = (const bf16_t*)(ws + WS_R2); bf16_t* YA = (bf16_t*)(ws + WS_R0);
    const float* VSTAT = (const float*)(ws + WS_VSTAT); const bf16_t* WM = (const bf16_t*)(ws + WS_WM);
    const float* lng = p.in[3]; const float* lnb = p.in[4]; const float* bs = p.in[6];
    LAS float* MU = (LAS float*)(c.lds + 2 * 128 * 272);
    const int fr = c.lane & 15, fq = c.lane >> 4, wi = c.wave >> 1, wj = c.wave & 1;
    const int c8 = c.tid & 15, jb = c.tid >> 4;
    for (int nb = nb0; nb < 256; nb += nbstride) {
        const int tok0 = nb * 128;
        u32x4 vr[4];
#pragma unroll
        for (int e = 0; e < 4; ++e) vr[e] = *(const u32x4*)(V + (size_t)(tok0 + jb + 32 * e) * DM + c8 * 8);
        __syncthreads();
        if (c.tid < 128) {
            const f32x4* sp = (const f32x4*)(VSTAT + (size_t)(tok0 + c.tid) * 32); float s = 0.f, q = 0.f;
#pragma unroll
            for (int i = 0; i < 8; ++i) { const f32x4 w = sp[i]; s += w[0] + w[2]; q += w[1] + w[3]; }
            const float mu = s * (1.0f / DM), var = fmaxf(q * (1.0f / DM) - mu * mu, 0.f);
            MU[c.tid] = mu; MU[128 + c.tid] = 1.0f / sqrtf(var + EPSV);
        }
        __syncthreads();
        float mu4[4], rs4[4];
#pragma unroll
        for (int e = 0; e < 4; ++e) { mu4[e] = MU[jb + 32 * e]; rs4[e] = MU[128 + jb + 32 * e]; }
        for (int g = 0; g < 8; ++g) {
            LAS bf16_t* VT = (LAS bf16_t*)(c.lds + (g & 1) * 128 * 272);
            { const int ch = g * 128 + c8 * 8;
                const f32x4 g0 = *(const f32x4*)(lng + ch), g1 = *(const f32x4*)(lng + ch + 4), b0 = *(const f32x4*)(lnb + ch), b1 = *(const f32x4*)(lnb + ch + 4);
#pragma unroll
                for (int e = 0; e < 4; ++e) {
                    const int j = jb + 32 * e; float v[8]; unpack8(vr[e], v);
#pragma unroll
                    for (int i = 0; i < 8; ++i) { const float vn = (v[i] - mu4[e]) * rs4[e] * (i < 4 ? g0[i & 3] : g1[i & 3]) + (i < 4 ? b0[i & 3] : b1[i & 3]);
                        VT[(c8 * 8 + i) * 136 + j] = (bf16_t)(cvt_pk_bf16(vn, 0.f) & 0xffffu); }
                }
            }
            if (g < 7) {
#pragma unroll
                for (int e = 0; e < 4; ++e) vr[e] = *(const u32x4*)(V + (size_t)(tok0 + jb + 32 * e) * DM + (g + 1) * 128 + c8 * 8);
            }
            u32x2 uu[2][4]; float bsv[2];
#pragma unroll
            for (int mf = 0; mf < 2; ++mf) { const int i = 32 * wi + 16 * mf + fr; bsv[mf] = bs[g * 128 + i];
#pragma unroll
                for (int nf = 0; nf < 4; ++nf) uu[mf][nf] = *(const u32x2*)(U + (size_t)(tok0 + i) * DM + g * 128 + 64 * wj + 16 * nf + 4 * fq); }
            bf16x8 af[4][2];
#pragma unroll
            for (int kk = 0; kk < 4; ++kk)
#pragma unroll
                for (int mf = 0; mf < 2; ++mf) af[kk][mf] = *(const bf16x8*)(WM + ((size_t)g * 128 + 32 * wi + 16 * mf + fr) * 128 + 32 * kk + 8 * fq);
            __syncthreads();
            f32x4 acc[2][4];
#pragma unroll
            for (int a = 0; a < 2; ++a)
#pragma unroll
                for (int b = 0; b < 4; ++b) acc[a][b] = (f32x4){0.f, 0.f, 0.f, 0.f};
#pragma unroll
            for (int kk = 0; kk < 4; ++kk) {
                bf16x8 bfr[4];
#pragma unroll
                for (int nf = 0; nf < 4; ++nf) bfr[nf] = *(const LAS bf16x8*)(VT + (64 * wj + 16 * nf + fr) * 136 + 32 * kk + 8 * fq);
#pragma unroll
                for (int mf = 0; mf < 2; ++mf)
#pragma unroll
                    for (int nf = 0; nf < 4; ++nf) acc[mf][nf] = __builtin_amdgcn_mfma_f32_16x16x32_bf16(bfr[nf], af[kk][mf], acc[mf][nf], 0, 0, 0);
            }
#pragma unroll
            for (int mf = 0; mf < 2; ++mf) {
                const int i = 32 * wi + 16 * mf + fr;
#pragma unroll
                for (int nf = 0; nf < 4; ++nf) {
                    const size_t off = (size_t)(tok0 + i) * DM + g * 128 + 64 * wj + 16 * nf + 4 * fq; const u32x2 w = uu[mf][nf];
                    const f32x2 ga = gelu2((f32x2){bf_lo(w[0]), bf_hi(w[0])}), gb = gelu2((f32x2){bf_lo(w[1]), bf_hi(w[1])});
                    const float o0 = ga.x * (acc[mf][nf][0] + bsv[mf]), o1 = ga.y * (acc[mf][nf][1] + bsv[mf]), o2 = gb.x * (acc[mf][nf][2] + bsv[mf]), o3 = gb.y * (acc[mf][nf][3] + bsv[mf]);
                    *(u32x2*)(YA + off) = (u32x2){cvt_pk_bf16(o0, o1), cvt_pk_bf16(o2, o3)};
                }
            }
        }
    }
    __syncthreads();
}
__device__ __forceinline__ void p2_toeplitz(const Ctx& c, const Params& p) {
    const float* KTAB = (const float*)(p.ws + WS_KTAB); bf16_t* TOEP = (bf16_t*)(p.ws + WS_TOEP);
    for (int item = c.bx; item < 256; item += c.G) {
        const int g = item >> 3, r = item & 7;
#pragma unroll
        for (int e = 0; e < 8; ++e) {
            const int idx = c.tid + NTHR * e; const int rl = idx >> 6, c8 = idx & 63;
            const int t = 4 * r + (rl >> 4), ho = rl & 15, s = c8 >> 1, hi0 = (c8 & 1) * 8;
            u32x4 o = (u32x4){0u, 0u, 0u, 0u};
            if (s <= t) { const float* kp = KTAB + (size_t)(g * 32 + (t - s)) * 256 + ho * 16 + hi0; const f32x4 k0 = *(const f32x4*)kp, k1 = *(const f32x4*)(kp + 4);
                o = (u32x4){cvt_pk_bf16(k0[0], k0[1]), cvt_pk_bf16(k0[2], k0[3]), cvt_pk_bf16(k1[0], k1[1]), cvt_pk_bf16(k1[2], k1[3])}; }
            *(u32x4*)(TOEP + ((size_t)g * 512 + t * 16 + ho) * XGW + s * 16 + hi0) = o;
        }
    }
}
template <bool FROM_LDS = false>
__device__ __forceinline__ void s5_scan_item(const Ctx& c, const Params& p, int item) {
    const float* S = (const float*)(p.ws + WS_S); const float* A32 = (const float*)(p.ws + WS_A32); bf16_t* XGE = (bf16_t*)(p.ws + WS_XGE);
    LAS float* L = (LAS float*)c.lds;
    int tid = c.tid; asm volatile("" : "+v"(tid));
    const int g = item >> 2, b = item & 3; const size_t row0 = (size_t)g * NCH + b * NCHB;
    __syncthreads();
    if (!FROM_LDS) {
        const f32x4* src = (const f32x4*)(S + row0 * 128);
#pragma unroll
        for (int e = 0; e < 16; ++e) { const int idx = tid + NTHR * e; *(LAS f32x4*)(L + idx * 4) = src[idx]; }
        __syncthreads();
    }
    if (tid < 64) {
        const int pi = tid; const float ar = A32[(g * 64 + pi) * 2], ai = A32[(g * 64 + pi) * 2 + 1]; float hr = 0.f, him = 0.f;
        bf16_t* dst = XGE + row0 * XGW + 512 + pi;
#pragma unroll 8
        for (int ch = 0; ch < NCHB; ++ch) {
            const float sr = L[ch * 128 + pi], si = L[ch * 128 + 64 + pi];
            const unsigned w = cvt_pk_bf16(hr, him);
            dst[(size_t)ch * XGW] = (bf16_t)(w & 0xffffu); dst[(size_t)ch * XGW + 64] = (bf16_t)(w >> 16);
            const float t0 = ar * hr - ai * him + sr, t1 = ar * him + ai * hr + si; hr = t0; him = t1;
        }
    }
    asm volatile("s_waitcnt vmcnt(0)" ::: "memory");
    __syncthreads();
}
__device__ __forceinline__ void p10_final_norm(const Ctx& c, const Params& p) {
    const float* PART = (const float*)(p.ws + WS_RSFP); const float* gf = p.in[24]; float* out = p.out; const bf16_t* X2 = (const bf16_t*)(p.ws + WS_R4);
    f32x4 gv[2][2];
#pragma unroll
    for (int j = 0; j < 2; ++j) { gv[j][0] = *(const f32x4*)(gf + j * 512 + c.lane * 8); gv[j][1] = *(const f32x4*)(gf + j * 512 + c.lane * 8 + 4); }
    for (int row = c.bx * 8 + c.wave; row < T_TOK; row += c.G * 8) {
        const f32x4* pp = (const f32x4*)(PART + (size_t)row * 16); const f32x4 p0 = pp[0], p1 = pp[1], p2 = pp[2], p3 = pp[3];
        const u32x4 w0 = *(const u32x4*)(X2 + (size_t)row * DM + c.lane * 8), w1 = *(const u32x4*)(X2 + (size_t)row * DM + 512 + c.lane * 8);
        const float ss = ((p0[0] + p0[1]) + (p0[2] + p0[3])) + ((p1[0] + p1[1]) + (p1[2] + p1[3])) + ((p2[0] + p2[1]) + (p2[2] + p2[3])) + ((p3[0] + p3[1]) + (p3[2] + p3[3]));
        const float rs = 1.0f / sqrtf(ss * (1.0f / DM) + EPSV);
        float* xr = out + (size_t)row * DM;
        float a[8], b[8]; unpack8(w0, a); unpack8(w1, b);
        __builtin_nontemporal_store((f32x4){a[0], a[1], a[2], a[3]} * rs * gv[0][0], (f32x4*)(xr + c.lane * 8));
        __builtin_nontemporal_store((f32x4){a[4], a[5], a[6], a[7]} * rs * gv[0][1], (f32x4*)(xr + c.lane * 8 + 4));
        __builtin_nontemporal_store((f32x4){b[0], b[1], b[2], b[3]} * rs * gv[1][0], (f32x4*)(xr + 512 + c.lane * 8));
        __builtin_nontemporal_store((f32x4){b[4], b[5], b[6], b[7]} * rs * gv[1][1], (f32x4*)(xr + 512 + c.lane * 8 + 4));
    }
}

__global__ void __launch_bounds__(NTHR, 2) hybrid_fwd(Params p) {
    extern __shared__ __attribute__((aligned(16))) unsigned char shm[];
    Ctx c; c.lds = (LAS unsigned char*)shm; c.tid = threadIdx.x; c.lane = c.tid & 63; c.wave = __builtin_amdgcn_readfirstlane(c.tid >> 6); c.G = gridDim.x; c.bx = blockIdx.x;
    unsigned char* ws = p.ws;
    const int lo = p.ph_lo, hi = p.ph_hi;
#ifndef MK_ONLYPH
#define MK_ONLYPH -1
#endif
#define IN(k) ((MK_ONLYPH) < 0 ? (lo <= (k) && (k) < hi) : ((k) == (MK_ONLYPH)))
    if (c.tid < 4) ((LAS unsigned*)(c.lds + LDS_STAGE))[c.tid] = 0u;
    __syncthreads();
    XcdBarrier bar = xcd_barrier_post((unsigned*)(ws + WS_BAR), (volatile LAS unsigned*)(c.lds + LDS_STAGE));
    if (p.ph_hi > 1000) cg::this_grid().sync();
#define GSYNC() xcd_barrier(bar)
#define SEAM(k) do { if (IN(k) && IN((k) + 1)) GSYNC(); } while (0)
#define REP(k) for (int _r = 0; _r < ((MK_REPEAT) == (k) ? 2 : 1); ++_r)
#define REPSYNC(k) do { if ((MK_REPEAT) == (k) && _r == 0) GSYNC(); } while (0)
    bf16_t* R0 = (bf16_t*)(ws + WS_R0); bf16_t* R1 = (bf16_t*)(ws + WS_R1); bf16_t* R2 = (bf16_t*)(ws + WS_R2); bf16_t* R3 = (bf16_t*)(ws + WS_R3); bf16_t* R4 = (bf16_t*)(ws + WS_R4);
    bf16_t* XGE = (bf16_t*)(ws + WS_XGE); bf16_t* YB0 = (bf16_t*)p.out; bf16_t* YB = YB0 + (size_t)T_TOK * S5W;
    if (IN(0)) REP(0) {
        if (c.bx & 8) {
            p0_s5_tables(c, p);
            p0_wm(c, p.in[5], (bf16_t*)(ws + WS_WM));
            p0_convert_x(c, p.in[0], (bf16_t*)(ws + WS_XB), (float*)(ws + WS_RSTD1));
            p0_weights(c, p, 0, 288, 0, c.G);
        } else {
            p0_convert_x(c, p.in[0], (bf16_t*)(ws + WS_XB), (float*)(ws + WS_RSTD1));
            p0_weights(c, p, 0, 288, 0, c.G);
            p0_s5_tables(c, p);
            p0_wm(c, p.in[5], (bf16_t*)(ws + WS_WM));
        }
        REPSYNC(0);
    }
    SEAM(0);
    if (IN(1)) REP(1) {
        p2_toeplitz(c, p);
        pg8::Gemm g{(const bf16_t*)(ws + WS_XB), (const bf16_t*)(ws + WS_WIN), DM, DM, DM}; pg8::StaticOrder S; S.init(T_TOK, INW, c.G, c.bx, MK_WGM_BIG);
        EpiProj E{(const float*)(ws + WS_RSTD1), R1, R2, (float*)(ws + WS_VSTAT), XGE, R3, R4};
        pg8::gemm_phase(c.lds, g, S, E);
        REPSYNC(1);
    }
    SEAM(1);
    if (IN(2)) {
        const int nc = (c.G >= 256) ? 128 : (c.G > 1 ? c.G / 2 : 1), ng = c.G - nc;
        constexpr int NW1 = 704;
        if (c.bx < nc || ng <= 0) {
#pragma nounroll
            for (int pm = __builtin_amdgcn_readfirstlane(c.bx); pm < 128; pm += nc) {
                { pg8::Gemm g{XGE, (const bf16_t*)(ws + WS_M1), 512, XGW, 512}; pg8::OneStateUnit S{pm}; EpiStateLds E{(LAS float*)c.lds}; pg8::gemm_phase<1, false, true>(c.lds, g, S, E); }
                s5_scan_item<true>(c, p, pm);
                { pg8::Gemm g{XGE, (const bf16_t*)(ws + WS_TOEP), XGW, XGW, XGW}; pg8::PanelPair S{pm}; EpiS5Out E{YB0}; pg8::gemm_phase(c.lds, g, S, E); }
            }
            if (ng > 0) p0_weights(c, p, 288, 288 + NW1, 0, nc); else { p0_weights(c, p, 288, 992, 0, nc); p2_gmlp_mix(c, p, c.bx, nc); }
        } else {
            p0_weights(c, p, 288 + NW1, 992, nc, ng);
            p2_gmlp_mix(c, p, c.bx - nc, ng);
        }
    }
    do { if (IN(2) && IN(5)) GSYNC(); } while (0);
    if (IN(5)) REP(5) {
        pg8::Gemm g{YB0, (const bf16_t*)(ws + WS_WGLU), S5W, S5W, S5W}; pg8::StaticOrder S; S.init(T_TOK, S5W, c.G, c.bx); EpiGlu E{YB0, YB, p.in[16], DM};
        pg8::gemm_phase(c.lds, g, S, E);
        REPSYNC(5);
    }
    SEAM(5);
    if (IN(6)) {
        pg8::SegOrder S; S.S.init(T_TOK, DM, c.G, c.bx); S.a0 = (const char*)YB; S.b0 = (const char*)(ws + WS_PB); S.a1 = (const char*)R0; S.b1 = (const char*)(ws + WS_PA); S.pitch = (size_t)DM * 2;
        pg8::Gemm g{nullptr, nullptr, DM, DM, DM}; EpiMergeSeg E{R3, R4, R1};
        pg8::gemm_phase<1, true>(c.lds, g, S, E);
    }
    SEAM(6);
    if (IN(7)) REP(7) {
        pg8::Gemm g{R1, (const bf16_t*)(ws + WS_WOUT), DM, DM, DM}; pg8::StaticOrder S; S.init(T_TOK, DM, c.G, c.bx);
        EpiResid<2> E{ws + WS_XB, R0, (float*)(ws + WS_RS2P), (const float*)(ws + WS_RSTD1)};
        pg8::gemm_phase(c.lds, g, S, E);
        REPSYNC(7);
    }
    SEAM(7);
    if (IN(8)) REP(8) {
        pg8::Gemm g{R0, (const bf16_t*)(ws + WS_WGU), DM, DM, DM}; pg8::StaticOrder S; S.init(T_TOK, 2 * FFH, c.G, c.bx, MK_WGM_BIG);
        LAS float* RSL = (LAS float*)(c.lds + LDS_RSTD);
        {
            const float* PART = (const float*)(ws + WS_RS2P); pg8::Unit u;
            for (int i = 0; i < 12 && S.next(i, u); ++i)
                if (c.tid < 256) { const f32x4* pp = (const f32x4*)(PART + (size_t)(u.pm * 256 + c.tid) * 16); const f32x4 p0 = pp[0], p1 = pp[1], p2 = pp[2], p3 = pp[3];
                    const float ss = ((p0[0] + p0[1]) + (p0[2] + p0[3])) + ((p1[0] + p1[1]) + (p1[2] + p1[3])) + ((p2[0] + p2[1]) + (p2[2] + p2[3])) + ((p3[0] + p3[1]) + (p3[2] + p3[3]));
                    RSL[i * 256 + c.tid] = __builtin_amdgcn_rsqf(ss * (1.0f / DM) + EPSV); }
            __syncthreads();
        }
        EpiGateUp E{RSL, R1};
        pg8::gemm_phase<((MK_REPEAT) == 20 ? 2 : ((MK_REPEAT) == 21 ? -1 : 1))>(c.lds, g, S, E);
        REPSYNC(8);
    }
    SEAM(8);
    if (IN(9)) {
        pg8::Gemm g{R1, (const bf16_t*)(ws + WS_WD), FFH, FFH, FFH}; pg8::StaticOrder S; S.init(T_TOK, DM, c.G, c.bx);
        if (c.G == 256) {
            EpiFinal E{R0, p.out, (float*)(ws + WS_RSFP), (unsigned*)(ws + WS_PCNT), p.in[24]};
            pg8::gemm_phase(c.lds, g, S, E);
        } else {
            EpiResid<1> E{R0, R4, (float*)(ws + WS_RSFP), nullptr};
            pg8::gemm_phase(c.lds, g, S, E);
            GSYNC();
            p10_final_norm(c, p);
        }
    }
    if ((MK_REPEAT) == 11) for (int i = 0; i < 8; ++i) GSYNC();
#undef IN
#undef SEAM
}

extern "C" void kernel_launch(void* const* d_in, const int* in_sizes, int n_in, void* d_out, int out_size, void* d_ws, size_t ws_size, hipStream_t stream) {
    static int grid = 0;
    if (grid == 0) {
        if (n_in != 25 || out_size != T_TOK * DM || ws_size < WS_END) { fprintf(stderr, "kernel_launch: unexpected shapes (n_in %d out %d ws %zu)\n", n_in, out_size, ws_size); grid = -1; return; }
        int dev = 0, cus = 0, per_cu = 0;
        hipGetDevice(&dev); hipDeviceGetAttribute(&cus, hipDeviceAttributeMultiprocessorCount, dev);
        if (hipFuncSetAttribute((const void*)hybrid_fwd, hipFuncAttributeMaxDynamicSharedMemorySize, LDS_BYTES) != hipSuccess) { fprintf(stderr, "kernel_launch: hipFuncSetAttribute failed\n"); grid = -1; return; }
        if (hipOccupancyMaxActiveBlocksPerMultiprocessor(&per_cu, (const void*)hybrid_fwd, NTHR, LDS_BYTES) != hipSuccess || per_cu < 1) { fprintf(stderr, "kernel_launch: occupancy query gave %d\n", per_cu); per_cu = 1; }
        (void)hipGetLastError();
        grid = cus;
    }
    if (grid < 0) return;
    Params p{};
    for (int i = 0; i < 25; ++i) p.in[i] = (const float*)d_in[i];
    p.out = (float*)d_out; p.ws = (unsigned char*)d_ws;
    (void)hipMemsetAsync((unsigned char*)d_ws + WS_BAR, 0, 16384 + 128 * 256, stream);
#if MK_PER_PHASE
    for (int ph = 0; ph <= 10; ++ph) { p.ph_lo = ph; p.ph_hi = ph + 1; hipLaunchKernelGGL(hybrid_fwd, dim3(grid), dim3(NTHR), LDS_BYTES, stream, p); }
#else
    p.ph_lo = 0; p.ph_hi = 11;
    void* args[] = {&p};
    hipError_t e = hipLaunchCooperativeKernel((const void*)hybrid_fwd, dim3(grid), dim3(NTHR), args, LDS_BYTES, stream);
    if (e != hipSuccess) fprintf(stderr, "cooperative launch failed: %s (grid %d)\n", hipGetErrorString(e), grid);
#endif
}
```

```cpp
#include <hip/hip_runtime.h>
#include <hip/hip_cooperative_groups.h>
#include <cstdio>
namespace cg = cooperative_groups;

#ifndef MK_PER_PHASE
#define MK_PER_PHASE 0
#endif

#ifndef MK_WGM_BIG
#define MK_WGM_BIG 4
#endif
#ifndef MK_REPEAT
#define MK_REPEAT -1
#endif
#define LAS __attribute__((address_space(3)))
typedef unsigned short bf16_t;
typedef short bf16x8 __attribute__((ext_vector_type(8)));
typedef float f32x4 __attribute__((ext_vector_type(4)));
typedef float f32x2 __attribute__((ext_vector_type(2)));
typedef unsigned u32x4 __attribute__((ext_vector_type(4)));
typedef unsigned u32x2 __attribute__((ext_vector_type(2)));

constexpr int T_TOK = 32768, DM = 1024, INW = 4608, FFH = 2816, S5W = 512, S5G = 32, S5P = 64, S5H = 16;
constexpr int TC = 32;
constexpr int NCHB = 8192 / TC;
constexpr int NCH = T_TOK / TC;
constexpr int XGW = TC * S5H + 2 * S5P;
constexpr float EPSV = 1e-6f;
constexpr int NTHR = 512;
constexpr int LDS_STAGE = 131072;
constexpr int LDS_RSTD = LDS_STAGE + 16;
constexpr int LDS_BYTES = LDS_RSTD + 12 * 256 * 4;

constexpr size_t MiB = 1048576;
constexpr size_t WS_R0 = 0 * MiB;
constexpr size_t WS_R1 = 64 * MiB;
constexpr size_t WS_R2 = 128 * MiB;
constexpr size_t WS_R3 = 192 * MiB;
constexpr size_t WS_R4 = 256 * MiB;
constexpr size_t WS_XGE = 320 * MiB;
constexpr size_t WS_TOEP = 360 * MiB;
constexpr size_t WS_M1 = 380 * MiB;
constexpr size_t WS_S = 385 * MiB;
constexpr size_t WS_WIN = 401 * MiB;
constexpr size_t WS_WGLU = 410 * MiB;
constexpr size_t WS_PA = 411 * MiB;
constexpr size_t WS_PB = 439 * MiB;
constexpr size_t WS_WOUT = 414 * MiB;
constexpr size_t WS_WGU = 416 * MiB;
constexpr size_t WS_WD = 427 * MiB;
constexpr size_t WS_VSTAT = 433 * MiB;
constexpr size_t WS_RS2P = 437 * MiB;
constexpr size_t WS_RSFP = 439 * MiB;
constexpr size_t WS_RSTD1 = 441 * MiB;
constexpr size_t WS_KTAB = 442 * MiB;
constexpr size_t WS_A32 = 443 * MiB;
constexpr size_t WS_WM = 444 * MiB;
constexpr size_t WS_BAR = 446 * MiB;
constexpr size_t WS_PCNT = WS_BAR + 16384;
constexpr size_t WS_XB = 447 * MiB;
constexpr size_t WS_END = 511 * MiB;

struct Params { const float* in[25]; float* out; unsigned char* ws; int ph_lo, ph_hi; };

typedef __bf16 bf16x2_t __attribute__((ext_vector_type(2)));
__device__ __forceinline__ unsigned cvt_pk_bf16(float lo, float hi) { const f32x2 f = {lo, hi}; const bf16x2_t b = __builtin_convertvector(f, bf16x2_t); return __builtin_bit_cast(unsigned, b); }
__device__ __forceinline__ float bf_lo(unsigned w) { return __uint_as_float(w << 16); }
__device__ __forceinline__ float bf_hi(unsigned w) { return __uint_as_float(w & 0xffff0000u); }
__device__ __forceinline__ float sigmoid_f(float x) { return __builtin_amdgcn_rcpf(1.0f + __builtin_amdgcn_exp2f(-1.442695041f * x)); }
__device__ __forceinline__ float gelu_t(float x) {
    const float z = x * (0.7978845608f + 0.0356774081f * x * x);
    return x * __builtin_amdgcn_rcpf(1.0f + __builtin_amdgcn_exp2f(-2.885390082f * z));
}
__device__ __forceinline__ float silu_f(float x) { return x * sigmoid_f(x); }
__device__ __forceinline__ f32x2 gelu2(f32x2 x) {
    const f32x2 t = x * ((x * x) * (-0.1029432397f) + (-2.302208198f));
    f32x2 e; e.x = __builtin_amdgcn_exp2f(t.x); e.y = __builtin_amdgcn_exp2f(t.y);
    const f32x2 d = e + 1.0f;
    f32x2 r; r.x = __builtin_amdgcn_rcpf(d.x); r.y = __builtin_amdgcn_rcpf(d.y);
    return x * r;
}
__device__ __forceinline__ void gelu8(float (&v)[8]) {
#pragma unroll
    for (int i = 0; i < 8; i += 2) { const f32x2 g = gelu2((f32x2){v[i], v[i + 1]}); v[i] = g.x; v[i + 1] = g.y; }
}
__device__ __forceinline__ u32x4 pack8(const float (&v)[8]) { u32x4 r; r[0] = cvt_pk_bf16(v[0], v[1]); r[1] = cvt_pk_bf16(v[2], v[3]); r[2] = cvt_pk_bf16(v[4], v[5]); r[3] = cvt_pk_bf16(v[6], v[7]); return r; }
__device__ __forceinline__ void unpack8(const u32x4 w, float (&v)[8]) {
#pragma unroll
    for (int i = 0; i < 4; ++i) { v[2 * i] = bf_lo(w[i]); v[2 * i + 1] = bf_hi(w[i]); }
}


#define XB_TMO      128
#define XB_XCNT(j)  (256  + 64 * (j))
#define XB_XSUB(j)  (1280 + 64 * (j))
#define XB_XGEN(j)  (2304 + 64 * (j))
#define XB_TOP      3328
#define XB_TOPGEN   3392
#define XCD_BAR_WORDS 3456
#define XB_SPIN_CAP (1u << 22)
__device__ __forceinline__ unsigned xb_ld(unsigned* p)              { return __hip_atomic_load(p, __ATOMIC_RELAXED, __HIP_MEMORY_SCOPE_AGENT); }
__device__ __forceinline__ unsigned xb_add(unsigned* p, unsigned v) { return __hip_atomic_fetch_add(p, v, __ATOMIC_RELAXED, __HIP_MEMORY_SCOPE_AGENT); }
__device__ __forceinline__ unsigned xb_xcc_id() { return (unsigned)__builtin_amdgcn_s_getreg((3 << 11) | 20) & 0xFu; }
#define XB_SPIN(cond, bar) do { unsigned _sp = 0; while (cond) { __builtin_amdgcn_s_sleep(1); \
    if ((++_sp & 255u) == 0u) { if (xb_ld(&(bar)[XB_TMO])) break; if (_sp > XB_SPIN_CAP) { atomicAdd(&(bar)[XB_TMO], 1u); break; } } } } while (0)
struct XcdBarrier { unsigned* bar; unsigned x; volatile LAS unsigned* st; };
__device__ __forceinline__ XcdBarrier xcd_barrier_post(unsigned* bar, volatile LAS unsigned* st) {
    XcdBarrier b; b.bar = bar; b.x = xb_xcc_id(); b.st = st;
    if (threadIdx.x == 0) (void)xb_add(&bar[XB_XCNT(b.x)], 1u);
    return b;
}
__device__ __forceinline__ void xcd_barrier_complete(unsigned* bar, unsigned x, unsigned& nloc, unsigned& nx) {
    const unsigned G = gridDim.x * gridDim.y * gridDim.z;
    unsigned sum, cnt, mine, sp = 0u;
    for (;;) {
        sum = 0u; cnt = 0u; mine = 0u;
#pragma unroll
        for (unsigned j = 0; j < 16; ++j) { const unsigned c = xb_ld(&bar[XB_XCNT(j)]); sum += c; cnt += (c > 0u) ? 1u : 0u; mine = (j == x) ? c : mine; }
        if (sum == G) break;
        __builtin_amdgcn_s_sleep(1);
        if ((++sp & 255u) == 0u) { if (xb_ld(&bar[XB_TMO])) break; if (sp > XB_SPIN_CAP) { atomicAdd(&bar[XB_TMO], 1u); break; } }
    }
    nloc = mine > 0u ? mine : 1u; nx = cnt > 0u ? cnt : 1u;
}
__device__ __forceinline__ void xcd_barrier(const XcdBarrier& b) {
    asm volatile("s_waitcnt vmcnt(0)" ::: "memory");
    __syncthreads();
    if (threadIdx.x == 0) {
        unsigned* bar = b.bar;
        __builtin_amdgcn_s_waitcnt(0);
        unsigned nloc = b.st[0], nx = b.st[1];
        if (nloc == 0u) { xcd_barrier_complete(bar, b.x, nloc, nx); b.st[0] = nloc; b.st[1] = nx; }
        const unsigned old = xb_add(&bar[XB_XSUB(b.x)], 1u);
        const unsigned gen = old / nloc;
        if (old + 1u == (gen + 1u) * nloc) {
            __builtin_amdgcn_fence(__ATOMIC_RELEASE, "agent");
            asm volatile("s_waitcnt vmcnt(0)" ::: "memory");
            const unsigned og = xb_add(&bar[XB_TOP], 1u);
            const unsigned tg = og / nx;
            if (og + 1u == (tg + 1u) * nx) xb_add(&bar[XB_TOPGEN], 1u);
            else XB_SPIN(xb_ld(&bar[XB_TOPGEN]) == tg, bar);
            __builtin_amdgcn_fence(__ATOMIC_ACQUIRE, "agent");
            xb_add(&bar[XB_XGEN(b.x)], 1u);
            asm volatile("s_waitcnt vmcnt(0)" ::: "memory");
        } else {
            XB_SPIN(xb_ld(&bar[XB_XGEN(b.x)]) == gen, bar);
            __builtin_amdgcn_fence(__ATOMIC_ACQUIRE, "agent");
            asm volatile("s_waitcnt vmcnt(0)" ::: "memory");
        }
    }
    __syncthreads();
}

namespace pg8 {
constexpr int BM = 256, BK = 64, HALF = 128, HTB = HALF * BK * 2, STAGE_BYTES = 8 * HTB, NXCD = 8, WGM = 8;
__host__ __device__ __forceinline__ int lds_byte(int r, int c) { const int st = (r >> 4) * 2 + (c >> 5), rr = r & 15, cc = c & 31, ob = rr * 64 + cc * 2; return st * 1024 + (ob ^ (((ob >> 9) & 1) << 5)); }
__host__ __device__ __forceinline__ void stage_rc(int b, int& R, int& C) { const int st = b / 1024, sb = b % 1024, swz = sb ^ (((sb >> 9) & 1) << 5); R = (st >> 1) * 16 + swz / 64; C = (st & 1) * 32 + (swz % 64) / 2; }
__host__ __device__ __forceinline__ int perm32(int rho) { const int n = rho >> 4, i = rho & 15; return 8 * (i >> 2) + 4 * n + (i & 3); }

struct Unit { int pm, pn, ra, rb, idx; const char* pa; const char* pb; int nt, kind; };
struct Gemm { const bf16_t* A; const bf16_t* Bt; int K, lda, ldb; };

struct StaticOrder {
    int nM, nN, nwg, G, c, wgm;
    __device__ void init(int M, int N, int G_, int c_, int wgm_ = WGM) { nM = M / BM; nN = N / BM; nwg = nM * nN; G = G_; c = c_; wgm = wgm_; }
    __device__ bool next(int i, Unit& u) const {
        const long L = (long)i * G + c; if (L >= nwg) return false;
        int wgid = (int)L; { const int q = nwg / NXCD, r = nwg % NXCD, xcd = wgid % NXCD, off = wgid / NXCD; wgid = (xcd < r ? xcd * (q + 1) : r * (q + 1) + (xcd - r) * q) + off; }
        const int nig = wgm * nN, gid = wgid / nig, fm = gid * wgm, gsz = (nM - fm) < wgm ? (nM - fm) : wgm;
        u.pm = fm + ((wgid % nig) % gsz); u.pn = (wgid % nig) / gsz; u.ra = u.pm * BM; u.rb = u.pn * BM; u.idx = i; return true;
    }
};
struct StateOrder {
    int G, c;
    __device__ bool next(int i, Unit& u) const { const int L = i * G + c; if (L >= 128) return false; u.pm = L; u.pn = 0; u.ra = L * BM; u.rb = (L >> 2) * 128; u.idx = i; return true; }
};
struct SegOrder {
    StaticOrder S; const char* a0; const char* b0; const char* a1; const char* b1; size_t pitch;
    __device__ bool next(int j, Unit& u) const {
        if (!S.next(j >> 1, u)) return false;
        u.idx = j; u.kind = j & 1; u.nt = (j & 1) ? 16 : 8;
        u.pa = ((j & 1) ? a1 : a0) + (size_t)u.ra * pitch; u.pb = ((j & 1) ? b1 : b0) + (size_t)u.rb * pitch; return true;
    }
};
struct OneStateUnit { int pm; __device__ bool next(int i, Unit& u) const { if (i > 0) return false; u.pm = pm; u.pn = 0; u.ra = pm * BM; u.rb = (pm >> 2) * 128; u.idx = 0; return true; } };
struct PanelPair { int pm; __device__ bool next(int i, Unit& u) const { if (i > 1) return false; u.pm = pm; u.pn = i; u.ra = pm * BM; u.rb = (pm >> 2) * 512 + i * BM; u.idx = i; return true; } };
struct S5OutOrder {
    int G, c;
    __device__ bool next(int i, Unit& u) const { const int L = i * G + c; if (L >= 256) return false; u.pm = L >> 1; u.pn = L & 1; u.ra = u.pm * BM; u.rb = (u.pm >> 2) * 512 + u.pn * BM; u.idx = i; return true; }
};

template <int KREP = 1, bool SEG = false, class Epi, class Sched>
__device__ __forceinline__ void gemm_phase(LAS unsigned char* lds, const Gemm g, const Sched& S, const Epi& E) {
    const int tid = threadIdx.x, wid = __builtin_amdgcn_readfirstlane(tid >> 6), lane = tid & 63, wr = wid >> 2, wc = wid & 3, fr = lane & 15, fq = lane >> 4;
    const int K = g.K, nt = K / BK;
    unsigned voffA[2], voffB[2];
#pragma unroll
    for (int i = 0; i < 2; ++i) { int R, C; stage_rc(tid * 16 + i * 8192, R, C); const int Rb = (R & ~31) + perm32(R & 31);
        voffA[i] = (unsigned)(R * g.lda + C) * 2u; voffB[i] = (unsigned)(Rb * g.ldb + C) * 2u; }
    const size_t kstep = (size_t)(BK * 2);
    const size_t hsA = (size_t)HALF * g.lda * 2, hsB = (size_t)HALF * g.ldb * 2;
    const size_t rowA = (size_t)g.lda * 2, rowB = (size_t)g.ldb * 2;
    const unsigned ldsw = (unsigned)wid * 1024u;
    const int aoff = lds_byte(wr * 64 + fr, fq * 8), boff = lds_byte(wc * 32 + fr, fq * 8);
#define PG8_SA(b, h) (((b) * 2 + (h)) * HTB)
#define PG8_SB(b, h) ((4 + (b) * 2 + (h)) * HTB)
#define PG8_STAGE(bufoff, gbase, voff) do { _Pragma("unroll") for (int _i = 0; _i < 2; ++_i) \
        __builtin_amdgcn_global_load_lds((const unsigned*)((const char*)(gbase) + (voff)[_i]), (LAS unsigned*)(lds + (bufoff) + ldsw + _i * 8192), 16, 0, 0); } while (0)
#define PG8_LDA(dst, b, h) do { _Pragma("unroll") for (int m = 0; m < 4; ++m) _Pragma("unroll") for (int k = 0; k < 2; ++k) dst[m][k] = *(const LAS bf16x8*)(lds + PG8_SA(b, h) + aoff + m * 2048 + k * 1024); } while (0)
#define PG8_LDB(dst, b, h) do { _Pragma("unroll") for (int n = 0; n < 2; ++n) _Pragma("unroll") for (int k = 0; k < 2; ++k) dst[n][k] = *(const LAS bf16x8*)(lds + PG8_SB(b, h) + boff + n * 2048 + k * 1024); } while (0)
#define PG8_MMA(ai, bj, At, Bt) do { __builtin_amdgcn_s_setprio(1); _Pragma("unroll") for (int m = 0; m < 4; ++m) _Pragma("unroll") for (int n = 0; n < 2; ++n) _Pragma("unroll") for (int k = 0; k < 2; ++k) \
        acc[ai][bj][m][n] = __builtin_amdgcn_mfma_f32_16x16x32_bf16(Bt[n][k], At[m][k], acc[ai][bj][m][n], 0, 0, 0); __builtin_amdgcn_s_setprio(0); } while (0)
#define PG8_WAIT_V(n) asm volatile("s_waitcnt vmcnt(" #n ")" ::: "memory")
#define PG8_WAIT_L(n) asm volatile("s_waitcnt lgkmcnt(" #n ")" ::: "memory")
#define PG8_BAR __builtin_amdgcn_s_barrier()
#define PG8_SCHED __builtin_amdgcn_sched_barrier(0)
    Unit cur, nxt; int ui = 0;
    if (!S.next(0, cur)) return;
    f32x4 acc[2][2][4][2];
#pragma unroll
    for (int a = 0; a < 2; ++a)
#pragma unroll
        for (int b = 0; b < 2; ++b)
#pragma unroll
            for (int m = 0; m < 4; ++m)
#pragma unroll
                for (int n = 0; n < 2; ++n) acc[a][b][m][n] = (f32x4){0.f, 0.f, 0.f, 0.f};
    bf16x8 At[4][2], B0[2][2], B1[2][2];
    const char* cA = SEG ? cur.pa : (const char*)g.A + (size_t)cur.ra * rowA; const char* cB = SEG ? cur.pb : (const char*)g.Bt + (size_t)cur.rb * rowB;
    PG8_STAGE(PG8_SB(0, 0), cB, voffB); PG8_STAGE(PG8_SA(0, 0), cA, voffA); PG8_STAGE(PG8_SB(0, 1), cB + hsB, voffB); PG8_STAGE(PG8_SA(0, 1), cA + hsA, voffA);
    if (wr == 1) PG8_BAR;
    PG8_WAIT_V(4); PG8_BAR;
    PG8_STAGE(PG8_SB(1, 0), cB + kstep, voffB); PG8_STAGE(PG8_SA(1, 0), cA + kstep, voffA); PG8_STAGE(PG8_SB(1, 1), cB + hsB + kstep, voffB);
    PG8_WAIT_V(6); PG8_BAR;
    for (;;) {
        const bool has_next = S.next(ui + 1, nxt);
        const char* nA = has_next ? (SEG ? nxt.pa : (const char*)g.A + (size_t)nxt.ra * rowA) : cA; const char* nB = has_next ? (SEG ? nxt.pb : (const char*)g.Bt + (size_t)nxt.rb * rowB) : cB;
        const int ntu = SEG ? cur.nt : nt;
        for (int kr = 0; kr < (KREP < 1 ? 1 : KREP); ++kr)
        for (int t = 0; t < ntu; t += 2) {
            const bool last = (t == ntu - 2);
            const char* a1 = cA + (size_t)(t + 1) * kstep;
            const char* a2 = last ? ((KREP > 1 && kr + 1 < KREP) ? cA : nA) : cA + (size_t)(t + 2) * kstep; const char* b2 = last ? ((KREP > 1 && kr + 1 < KREP) ? cB : nB) : cB + (size_t)(t + 2) * kstep;
            const char* a3 = a2 + kstep; const char* b3 = b2 + kstep;
            PG8_LDB(B0, 0, 0); PG8_SCHED; PG8_LDA(At, 0, 0); PG8_STAGE(PG8_SA(1, 1), a1 + hsA, voffA);
            PG8_WAIT_L(8); PG8_BAR; PG8_WAIT_L(0); PG8_MMA(0, 0, At, B0); PG8_BAR; PG8_SCHED;
            PG8_LDB(B1, 0, 1); PG8_STAGE(PG8_SB(0, 0), b2, voffB);
            PG8_BAR; PG8_WAIT_L(0); PG8_MMA(0, 1, At, B1); PG8_BAR;
            PG8_LDA(At, 0, 1); PG8_STAGE(PG8_SA(0, 0), a2, voffA);
            PG8_BAR; PG8_WAIT_L(0); PG8_MMA(1, 0, At, B0); PG8_BAR; PG8_SCHED;
            PG8_STAGE(PG8_SB(0, 1), b2 + hsB, voffB);
            PG8_WAIT_V(6); PG8_BAR; PG8_MMA(1, 1, At, B1); PG8_BAR;
            PG8_LDB(B0, 1, 0); PG8_SCHED; PG8_LDA(At, 1, 0); PG8_STAGE(PG8_SA(0, 1), a2 + hsA, voffA);
            PG8_WAIT_L(8); PG8_BAR; PG8_WAIT_L(0); PG8_MMA(0, 0, At, B0); PG8_BAR; PG8_SCHED;
            PG8_LDB(B1, 1, 1); PG8_STAGE(PG8_SB(1, 0), b3, voffB);
            PG8_BAR; PG8_WAIT_L(0); PG8_MMA(0, 1, At, B1); PG8_BAR;
            PG8_LDA(At, 1, 1); PG8_STAGE(PG8_SA(1, 0), a3, voffA);
            PG8_BAR; PG8_WAIT_L(0); PG8_MMA(1, 0, At, B0); PG8_BAR; PG8_SCHED;
            PG8_STAGE(PG8_SB(1, 1), b3 + hsB, voffB);
            PG8_WAIT_V(6); PG8_BAR; PG8_MMA(1, 1, At, B1); PG8_BAR;
        }
        asm volatile("" ::: "memory");
        if (wr == 0) PG8_BAR;
        asm volatile("" ::: "memory");
        E(acc, cur, wr, wc, fr, fq);
        if (KREP < 0) { asm volatile("" ::: "memory"); E(acc, cur, wr, wc, fr, fq); }
        if (!has_next) break;
        if (!(SEG && cur.kind == 0)) {
#pragma unroll
        for (int a = 0; a < 2; ++a)
#pragma unroll
            for (int b = 0; b < 2; ++b)
#pragma unroll
                for (int m = 0; m < 4; ++m)
#pragma unroll
                    for (int n = 0; n < 2; ++n) acc[a][b][m][n] = (f32x4){0.f, 0.f, 0.f, 0.f};
        }
        cur = nxt; cA = nA; cB = nB; ++ui;
        asm volatile("" ::: "memory");
        if (wr == 1) PG8_BAR;
        asm volatile("" ::: "memory");
    }
    PG8_WAIT_V(0);
    PG8_BAR;
#undef PG8_SA
#undef PG8_SB
#undef PG8_STAGE
#undef PG8_LDA
#undef PG8_LDB
#undef PG8_MMA
#undef PG8_WAIT_V
#undef PG8_WAIT_L
#undef PG8_BAR
#undef PG8_SCHED
}
}

typedef f32x4 AccT[2][2][4][2];
#define EPI_ROWS(u) for (int ai = 0; ai < 2; ++ai) for (int m = 0; m < 4; ++m)
#define EPI_LOAD8(v, ai, bj, m) do { _Pragma("unroll") for (int _q = 0; _q < 4; ++_q) { v[_q] = acc[ai][bj][m][0][_q]; v[4 + _q] = acc[ai][bj][m][1][_q]; } } while (0)

struct EpiProj {
    const float* rstd1; bf16_t* U; bf16_t* V; float* VSTAT; bf16_t* XGE; bf16_t* GA; bf16_t* GB;
    template <int KIND> __device__ __forceinline__ void seg(const AccT& acc, const pg8::Unit& u, int wr, int wc, int fr, int fq) const {
        const int row0 = u.pm * 256 + wr * 64 + fr, colb = u.pn * 256 + wc * 32 + 8 * fq;
        bf16_t* const gdst = (u.pn < 14) ? GA : GB; const int gofs = (u.pn < 14) ? 2560 : 3584;
#pragma unroll
        for (int ai = 0; ai < 2; ++ai) {
#pragma unroll
            for (int m = 0; m < 4; ++m) {
                const int row = row0 + ai * 128 + m * 16;
                float s = 0.f, q = 0.f;
#pragma unroll
                for (int bj = 0; bj < 2; ++bj) {
                    const int col = colb + bj * 128; float v[8]; EPI_LOAD8(v, ai, bj, m);
                    if (KIND == 0) {
                        *(u32x4*)(U + (size_t)row * DM + col) = pack8(v);
                    } else if (KIND == 1) {
                        gelu8(v);
#pragma unroll
                        for (int i = 0; i < 8; ++i) { s += v[i]; q += v[i] * v[i]; }
                        *(u32x4*)(V + (size_t)row * DM + (col - 1024)) = pack8(v);
                    } else if (KIND == 2) {
                        const int cl = col - 2048, gg = cl >> 4, hi0 = cl & 15;
                        *(u32x4*)(XGE + ((size_t)gg * NCH + (row >> 5)) * XGW + (row & 31) * 16 + hi0) = pack8(v);
                    } else if (bj == 0) {
                        float w[8]; EPI_LOAD8(w, ai, 1, m);
                        const int oc = (u.pn - 10) * 128 + wc * 32 + 8 * fq;
#pragma unroll
                        for (int i = 0; i < 8; ++i) { const float ea = fminf(__builtin_amdgcn_exp2f(-1.442695041f * v[i]), 1e30f), eb = fminf(__builtin_amdgcn_exp2f(-1.442695041f * w[i]), 1e30f);
                            v[i] = __builtin_amdgcn_rcpf(1.0f + ea); w[i] = (1.0f + ea) * __builtin_amdgcn_rcpf(1.0f + eb); }
                        *(u32x4*)(GA + (size_t)row * DM + oc) = pack8(v);
                        *(u32x4*)(GB + (size_t)row * DM + oc) = pack8(w);
                    }
                }
                if (KIND == 1) {
                    s += __shfl_xor(s, 16); q += __shfl_xor(q, 16); s += __shfl_xor(s, 32); q += __shfl_xor(q, 32);
                    if (fq == 0) *(f32x2*)(VSTAT + ((size_t)row * 16 + (u.pn - 4) * 4 + wc) * 2) = (f32x2){s, q};
                }
            }
        }
    }
    __device__ __forceinline__ void operator()(const AccT& acc, const pg8::Unit& u, int wr, int wc, int fr, int fq) const {
        if (u.pn < 4) seg<0>(acc, u, wr, wc, fr, fq);
        else if (u.pn < 8) seg<1>(acc, u, wr, wc, fr, fq);
        else if (u.pn < 10) seg<2>(acc, u, wr, wc, fr, fq);
        else seg<3>(acc, u, wr, wc, fr, fq);
    }
};
struct EpiState {
    float* S;
    __device__ __forceinline__ void operator()(const AccT& acc, const pg8::Unit& u, int wr, int wc, int fr, int fq) const {
        const int row0 = u.pm * 256 + wr * 64 + fr, col = wc * 32 + 8 * fq;
#pragma unroll
        for (int ai = 0; ai < 2; ++ai)
#pragma unroll
            for (int m = 0; m < 4; ++m) { float* p = S + (size_t)(row0 + ai * 128 + m * 16) * 128 + col; *(f32x4*)p = acc[ai][0][m][0]; *(f32x4*)(p + 4) = acc[ai][0][m][1]; }
    }
};
struct EpiS5Out {
    bf16_t* YB0;
    __device__ __forceinline__ void operator()(const AccT& acc, const pg8::Unit& u, int wr, int wc, int fr, int fq) const {
        const int row0 = u.pm * 256 + wr * 64 + fr, colb = u.pn * 256 + wc * 32 + 8 * fq;
#pragma unroll
        for (int ai = 0; ai < 2; ++ai)
#pragma unroll
            for (int m = 0; m < 4; ++m) {
                const int row = row0 + ai * 128 + m * 16, gg = row >> 10, n = row & 1023;
#pragma unroll
                for (int bj = 0; bj < 2; ++bj) {
                    const int col = colb + bj * 128, t = col >> 4, ho0 = col & 15; float v[8]; EPI_LOAD8(v, ai, bj, m);
                    gelu8(v);
                    *(u32x4*)(YB0 + (size_t)(n * TC + t) * S5W + gg * 16 + ho0) = pack8(v);
                }
            }
    }
};
struct EpiGlu {
    const bf16_t* YB0; bf16_t* YB; const float* bias; int ldy;
    __device__ __forceinline__ void operator()(const AccT& acc, const pg8::Unit& u, int wr, int wc, int fr, int fq) const {
        const int row0 = u.pm * 256 + wr * 64 + fr, colb = u.pn * 256 + wc * 32 + 8 * fq;
        f32x4 bq[2][2];
#pragma unroll
        for (int bj = 0; bj < 2; ++bj) { bq[bj][0] = *(const f32x4*)(bias + colb + bj * 128); bq[bj][1] = *(const f32x4*)(bias + colb + bj * 128 + 4); }
#pragma unroll
        for (int ai = 0; ai < 2; ++ai)
#pragma unroll
            for (int mp = 0; mp < 1; ++mp) {
                u32x4 yv[4][2];
#pragma unroll
                for (int mm = 0; mm < 4; ++mm)
#pragma unroll
                    for (int bj = 0; bj < 2; ++bj) yv[mm][bj] = *(const u32x4*)(YB0 + (size_t)(row0 + ai * 128 + mm * 16) * S5W + colb + bj * 128);
#pragma unroll
                for (int mm = 0; mm < 4; ++mm)
#pragma unroll
                    for (int bj = 0; bj < 2; ++bj) { const int m = mm;
                        float v[8], y[8]; EPI_LOAD8(v, ai, bj, m); unpack8(yv[mm][bj], y);
#pragma unroll
                        for (int i = 0; i < 8; ++i) v[i] = y[i] * sigmoid_f(v[i] + (i < 4 ? bq[bj][0][i & 3] : bq[bj][1][i & 3]));
                        *(u32x4*)(YB + (size_t)(row0 + ai * 128 + m * 16) * ldy + colb + bj * 128) = pack8(v); }
            }
    }
};
template <int ACCUM> struct EpiMerge {
    const bf16_t* GATE; bf16_t* MRG;
    __device__ __forceinline__ void operator()(const AccT& acc, const pg8::Unit& u, int wr, int wc, int fr, int fq) const {
        const int row0 = u.pm * 256 + wr * 64 + fr, colb = u.pn * 256 + wc * 32 + 8 * fq;
        constexpr int NB = ACCUM ? 2 : 4;
#pragma unroll
        for (int ai = 0; ai < 2; ++ai)
#pragma unroll
            for (int mb = 0; mb < 4; mb += NB) {
                u32x4 gv[NB][2], ov[NB][2];
#pragma unroll
                for (int mm = 0; mm < NB; ++mm)
#pragma unroll
                    for (int bj = 0; bj < 2; ++bj) { const size_t off = (size_t)(row0 + ai * 128 + (mb + mm) * 16) * DM + colb + bj * 128;
                        gv[mm][bj] = *(const u32x4*)(GATE + off); if (ACCUM) ov[mm][bj] = *(const u32x4*)(MRG + off); }
#pragma unroll
                for (int mm = 0; mm < NB; ++mm)
#pragma unroll
                    for (int bj = 0; bj < 2; ++bj) { const int m = mb + mm; const size_t off = (size_t)(row0 + ai * 128 + m * 16) * DM + colb + bj * 128;
                        float v[8], g[8]; EPI_LOAD8(v, ai, bj, m); unpack8(gv[mm][bj], g);
                        if (ACCUM) { float o[8]; unpack8(ov[mm][bj], o);
#pragma unroll
                            for (int i = 0; i < 8; ++i) v[i] = o[i] + g[i] * v[i]; }
                        else {
#pragma unroll
                            for (int i = 0; i < 8; ++i) v[i] = g[i] * v[i]; }
                        *(u32x4*)(MRG + off) = pack8(v); }
            }
    }
};
struct EpiMergeSeg {
    const bf16_t* GA; const bf16_t* GB; bf16_t* MRG;
    __device__ __forceinline__ void operator()(AccT& acc, const pg8::Unit& u, int wr, int wc, int fr, int fq) const {
        const int row0 = u.pm * 256 + wr * 64 + fr, colb = u.pn * 256 + wc * 32 + 8 * fq;
        if (u.kind == 0) {
#pragma unroll
            for (int ai = 0; ai < 2; ++ai) {
                u32x4 bv[4][2];
#pragma unroll
                for (int m = 0; m < 4; ++m)
#pragma unroll
                    for (int bj = 0; bj < 2; ++bj) bv[m][bj] = *(const u32x4*)(GB + (size_t)(row0 + ai * 128 + m * 16) * DM + colb + bj * 128);
#pragma unroll
                for (int m = 0; m < 4; ++m)
#pragma unroll
                    for (int bj = 0; bj < 2; ++bj) { float b[8]; unpack8(bv[m][bj], b);
                        acc[ai][bj][m][0] *= (f32x4){b[0], b[1], b[2], b[3]}; acc[ai][bj][m][1] *= (f32x4){b[4], b[5], b[6], b[7]}; }
            }
        } else {
#pragma unroll
            for (int ai = 0; ai < 2; ++ai) {
                u32x4 av[4][2];
#pragma unroll
                for (int m = 0; m < 4; ++m)
#pragma unroll
                    for (int bj = 0; bj < 2; ++bj) av[m][bj] = *(const u32x4*)(GA + (size_t)(row0 + ai * 128 + m * 16) * DM + colb + bj * 128);
#pragma unroll
                for (int m = 0; m < 4; ++m)
#pragma unroll
                    for (int bj = 0; bj < 2; ++bj) { float v[8], a[8]; EPI_LOAD8(v, ai, bj, m); unpack8(av[m][bj], a);
#pragma unroll
                        for (int i = 0; i < 8; ++i) v[i] *= a[i];
                        *(u32x4*)(MRG + (size_t)(row0 + ai * 128 + m * 16) * DM + colb + bj * 128) = pack8(v); }
            }
        }
    }
};
template <int RES_BF> struct EpiResid {
    const void* RES; bf16_t* XBF; float* PART; const float* RSC;
    __device__ __forceinline__ void operator()(const AccT& acc, const pg8::Unit& u, int wr, int wc, int fr, int fq) const {
        const int row0 = u.pm * 256 + wr * 64 + fr, colb = u.pn * 256 + wc * 32 + 8 * fq;
        constexpr int NB = RES_BF ? 4 : 2;
        constexpr bool SCALED = (RES_BF == 2);
#pragma unroll
        for (int ai = 0; ai < 2; ++ai)
#pragma unroll
            for (int mb = 0; mb < 4; mb += NB) {
                f32x4 rf[NB][2][2]; u32x4 rb[NB][2]; float rsc[NB];
#pragma unroll
                for (int mm = 0; mm < NB; ++mm) rsc[mm] = SCALED ? RSC[row0 + ai * 128 + (mb + mm) * 16] : 1.0f;
#pragma unroll
                for (int mm = 0; mm < NB; ++mm)
#pragma unroll
                    for (int bj = 0; bj < 2; ++bj) { const size_t off = (size_t)(row0 + ai * 128 + (mb + mm) * 16) * DM + colb + bj * 128;
                        if (RES_BF) rb[mm][bj] = *(const u32x4*)((const bf16_t*)RES + off);
                        else { rf[mm][bj][0] = *(const f32x4*)((const float*)RES + off); rf[mm][bj][1] = *(const f32x4*)((const float*)RES + off + 4); } }
#pragma unroll
                for (int mm = 0; mm < NB; ++mm) {
                    const int m = mb + mm, row = row0 + ai * 128 + m * 16; float q = 0.f;
#pragma unroll
                    for (int bj = 0; bj < 2; ++bj) {
                        const size_t off = (size_t)row * DM + colb + bj * 128;
                        float v[8], r[8]; EPI_LOAD8(v, ai, bj, m);
                        if (RES_BF) unpack8(rb[mm][bj], r);
                        else {
#pragma unroll
                            for (int i = 0; i < 4; ++i) { r[i] = rf[mm][bj][0][i]; r[4 + i] = rf[mm][bj][1][i]; } }
#pragma unroll
                        for (int i = 0; i < 8; ++i) { v[i] += SCALED ? r[i] * rsc[mm] : r[i]; q += v[i] * v[i]; }
                        *(u32x4*)(XBF + off) = pack8(v);
                    }
                    q += __shfl_xor(q, 16); q += __shfl_xor(q, 32);
                    if (fq == 0) PART[(size_t)row * 16 + u.pn * 4 + wc] = q;
                }
            }
    }
};
struct EpiFinal {
    const bf16_t* RES; float* OUT; float* PART; unsigned* CNT; const float* gf;
    __device__ __forceinline__ void operator()(const AccT& acc, const pg8::Unit& u, int wr, int wc, int fr, int fq) const {
        const int row0 = u.pm * 256 + wr * 64 + fr, colb = u.pn * 256 + wc * 32 + 8 * fq;
        f32x4 xv[2][2][4][2];
#pragma unroll
        for (int ai = 0; ai < 2; ++ai) {
            u32x4 rb[4][2];
#pragma unroll
            for (int m = 0; m < 4; ++m)
#pragma unroll
                for (int bj = 0; bj < 2; ++bj) rb[m][bj] = *(const u32x4*)(RES + (size_t)(row0 + ai * 128 + m * 16) * DM + colb + bj * 128);
#pragma unroll
            for (int m = 0; m < 4; ++m) {
                const int row = row0 + ai * 128 + m * 16; float q = 0.f;
#pragma unroll
                for (int bj = 0; bj < 2; ++bj) {
                    float v[8], r[8]; EPI_LOAD8(v, ai, bj, m); unpack8(rb[m][bj], r);
#pragma unroll
                    for (int i = 0; i < 8; ++i) { v[i] += r[i]; q += v[i] * v[i]; }
                    xv[ai][bj][m][0] = (f32x4){v[0], v[1], v[2], v[3]}; xv[ai][bj][m][1] = (f32x4){v[4], v[5], v[6], v[7]};
                }
                q += __shfl_xor(q, 16); q += __shfl_xor(q, 32);
                if (fq == 0) __hip_atomic_store(PART + (size_t)row * 16 + u.pn * 4 + wc, q, __ATOMIC_RELAXED, __HIP_MEMORY_SCOPE_AGENT);
            }
        }
        asm volatile("s_waitcnt vmcnt(0)" ::: "memory");
        __builtin_amdgcn_s_barrier();
        if (threadIdx.x == 0) {
            unsigned* cnt = CNT + 64 * u.pm;
            __hip_atomic_fetch_add(cnt, 1u, __ATOMIC_RELAXED, __HIP_MEMORY_SCOPE_AGENT);
            unsigned sp = 0;
            while (__hip_atomic_load(cnt, __ATOMIC_RELAXED, __HIP_MEMORY_SCOPE_AGENT) < 4u) { __builtin_amdgcn_s_sleep(1); if (++sp > (1u << 22)) break; }
            __builtin_amdgcn_fence(__ATOMIC_ACQUIRE, "agent");
            asm volatile("s_waitcnt vmcnt(0)" ::: "memory");
        }
        asm volatile("" ::: "memory");
        __builtin_amdgcn_s_barrier();
        asm volatile("" ::: "memory");
#pragma unroll
        for (int ai = 0; ai < 2; ++ai) {
            f32x4 pv[4];
#pragma unroll
            for (int m = 0; m < 4; ++m) pv[m] = *(const f32x4*)(PART + (size_t)(row0 + ai * 128 + m * 16) * 16 + 4 * fq);
            f32x4 gq[2][2];
#pragma unroll
            for (int bj = 0; bj < 2; ++bj) { gq[bj][0] = *(const f32x4*)(gf + colb + bj * 128); gq[bj][1] = *(const f32x4*)(gf + colb + bj * 128 + 4); }
#pragma unroll
            for (int m = 0; m < 4; ++m) {
                float ss = (pv[m][0] + pv[m][1]) + (pv[m][2] + pv[m][3]); ss += __shfl_xor(ss, 16); ss += __shfl_xor(ss, 32);
                const float rs = 1.0f / sqrtf(ss * (1.0f / DM) + EPSV);
#pragma unroll
                for (int bj = 0; bj < 2; ++bj) {
                    float* o = OUT + (size_t)(row0 + ai * 128 + m * 16) * DM + colb + bj * 128;
                    *(f32x4*)o = xv[ai][bj][m][0] * rs * gq[bj][0]; *(f32x4*)(o + 4) = xv[ai][bj][m][1] * rs * gq[bj][1];
                }
            }
        }
    }
};
struct EpiGateUp {
    const LAS float* RSL; bf16_t* ACT;
    __device__ __forceinline__ void operator()(const AccT& acc, const pg8::Unit& u, int wr, int wc, int fr, int fq) const {
        const int row0 = u.pm * 256 + wr * 64 + fr, colb = u.pn * 128 + wc * 32 + 8 * fq;
        float rs8[2][4];
#pragma unroll
        for (int ai = 0; ai < 2; ++ai)
#pragma unroll
            for (int m = 0; m < 4; ++m) rs8[ai][m] = RSL[u.idx * 256 + ai * 128 + wr * 64 + m * 16 + fr] * ((MK_REPEAT) == 20 ? 0.5f : 1.0f);
#pragma unroll
        for (int ai = 0; ai < 2; ++ai)
#pragma unroll
            for (int m = 0; m < 4; ++m) {
                const int row = row0 + ai * 128 + m * 16; const float rs = rs8[ai][m];
                const float rsl = rs * (-1.442695041f), rs2 = rs * rs;
                float gt[8], up[8], o[8]; EPI_LOAD8(gt, ai, 0, m); EPI_LOAD8(up, ai, 1, m);
#pragma unroll
                for (int i = 0; i < 8; i += 2) {
                    const f32x2 g2 = {gt[i], gt[i + 1]}, u2 = {up[i], up[i + 1]};
                    const f32x2 t = g2 * rsl; f32x2 e; e.x = __builtin_amdgcn_exp2f(t.x); e.y = __builtin_amdgcn_exp2f(t.y);
                    const f32x2 d = e + 1.0f; f32x2 r; r.x = __builtin_amdgcn_rcpf(d.x); r.y = __builtin_amdgcn_rcpf(d.y);
                    const f32x2 w = ((g2 * u2) * r) * rs2; o[i] = w.x; o[i + 1] = w.y;
                }
                *(u32x4*)(ACT + (size_t)row * FFH + colb) = pack8(o);
            }
    }
};

struct Ctx { LAS unsigned char* lds; int tid, lane, wave, G, bx; };

__device__ __forceinline__ void p0_convert_x(const Ctx& c, const float* x, bf16_t* XB, float* rstd1) {
    for (int base = c.bx * 128; base < T_TOK; base += c.G * 128) {
        for (int rr = 0; rr < 16; rr += 4) {
            const int row0 = base + c.wave * 16 + rr;
            f32x4 v[4][4];
#pragma unroll
            for (int r = 0; r < 4; ++r)
#pragma unroll
                for (int j = 0; j < 4; ++j) v[r][j] = __builtin_nontemporal_load((const f32x4*)(x + (size_t)(row0 + r) * DM + j * 256 + c.lane * 4));
#pragma unroll
            for (int r = 0; r < 4; ++r) {
                float q = 0.f;
#pragma unroll
                for (int j = 0; j < 4; ++j) q += v[r][j][0] * v[r][j][0] + v[r][j][1] * v[r][j][1] + v[r][j][2] * v[r][j][2] + v[r][j][3] * v[r][j][3];
#pragma unroll
                for (int o = 32; o >= 1; o >>= 1) q += __shfl_xor(q, o);
                const float rms = sqrtf(q * (1.0f / DM) + EPSV), rs = 1.0f / rms;
                if (c.lane == 0) rstd1[row0 + r] = rms;
#pragma unroll
                for (int j = 0; j < 4; ++j) *(u32x2*)(XB + (size_t)(row0 + r) * DM + j * 256 + c.lane * 4) = (u32x2){cvt_pk_bf16(v[r][j][0] * rs, v[r][j][1] * rs), cvt_pk_bf16(v[r][j][2] * rs, v[r][j][3] * rs)};
            }
        }
    }
}
__device__ __forceinline__ void transpose_quad(const Ctx& c, const float* W, int K, int N, const float* gs, bf16_t* Wt, int ldw, int map, int tk4, int tn) {
    LAS float* tile = (LAS float*)c.lds;
    const int k0 = tk4 * 256, n0 = tn * 64, nn = c.tid & 63, kq = c.tid >> 6;
    float v[32];
#pragma unroll
    for (int e = 0; e < 32; ++e) v[e] = W[(size_t)(k0 + kq + 8 * e) * N + n0 + nn];
    if (gs) {
#pragma unroll
        for (int e = 0; e < 32; ++e) v[e] *= gs[k0 + kq + 8 * e];
    }
#pragma unroll
    for (int e = 0; e < 32; ++e) tile[(kq + 8 * e) * 65 + nn] = v[e];
    __syncthreads();
    { const int ks = kq * 32; const int n = n0 + nn; const int dn = map == 0 ? n : (map == 3 ? (n < 2560 ? n : (n < 3584 ? 2560 + 256 * ((n - 2560) >> 7) + ((n - 2560) & 127) : 2560 + 256 * ((n - 3584) >> 7) + 128 + ((n - 3584) & 127))) : (256 * (n >> 7) + (n & 127) + (map == 2 ? 128 : 0)));
        bf16_t* dst = Wt + (size_t)dn * ldw + k0 + ks;
#pragma unroll
        for (int q = 0; q < 4; ++q) { float f[8];
#pragma unroll
            for (int j = 0; j < 8; ++j) f[j] = tile[(ks + q * 8 + j) * 65 + nn];
            *(u32x4*)(dst + q * 8) = pack8(f); } }
    __syncthreads();
}
__device__ __forceinline__ void p0_weights(const Ctx& c, const Params& p, int j0, int j1, int first, int nblk) {
    unsigned char* ws = p.ws;
    if (c.bx < first || c.bx >= first + nblk) return;
    for (int job = j0 + (c.bx - first); job < j1; job += nblk) {
        const float* W; int K, N, map = 0, t = job, ldw = 0; const float* gs = nullptr; bf16_t* Wt;
        if (job < 288) { W = p.in[2]; K = 1024; N = 4608; gs = p.in[1]; Wt = (bf16_t*)(ws + WS_WIN); map = 3; }
        else if (job < 304) { t = job - 288; W = p.in[15]; K = 512; N = 512; Wt = (bf16_t*)(ws + WS_WGLU); }
        else if (job < 368) { t = job - 304; W = p.in[17]; K = 1024; N = 1024; Wt = (bf16_t*)(ws + WS_PA); }
        else if (job < 400) { t = job - 368; W = p.in[18]; K = 512; N = 1024; Wt = (bf16_t*)(ws + WS_PB); ldw = 1024; }
        else if (job < 464) { t = job - 400; W = p.in[19]; K = 1024; N = 1024; Wt = (bf16_t*)(ws + WS_WOUT); }
        else if (job < 640) { t = job - 464; W = p.in[21]; K = 1024; N = 2816; gs = p.in[20]; Wt = (bf16_t*)(ws + WS_WGU); map = 1; }
        else if (job < 816) { t = job - 640; W = p.in[22]; K = 1024; N = 2816; gs = p.in[20]; Wt = (bf16_t*)(ws + WS_WGU); map = 2; }
        else { t = job - 816; W = p.in[23]; K = 2816; N = 1024; Wt = (bf16_t*)(ws + WS_WD); }
        const int nk = K / 256;
        transpose_quad(c, W, K, N, gs, Wt, ldw ? ldw : K, map, t % nk, t / nk);
    }
}
__device__ __forceinline__ void p0_s5_tables(const Ctx& c, const Params& p) {
    LAS float* AP = (LAS float*)c.lds;
    LAS float* BB = AP + 33 * 64 * 2;
    LAS float* CC = BB + 64 * 16 * 2;
    LAS float* DD = CC + 16 * 64 * 2;
    unsigned char* ws = p.ws;
    float* KTAB = (float*)(ws + WS_KTAB); bf16_t* M1 = (bf16_t*)(ws + WS_M1); bf16_t* TOEP = (bf16_t*)(ws + WS_TOEP); float* A32 = (float*)(ws + WS_A32);
    for (int item = c.bx; item < 256; item += c.G) {
        const int g = item >> 3, r = item & 7;
        __syncthreads();
        if (c.tid < 64) {
            const int pi = c.tid;
            const float dt = expf(p.in[9][g]), lr = p.in[7][g * 64 + pi], li = p.in[8][g * 64 + pi];
            const float mag = expf(lr * dt), are = mag * cosf(li * dt), aim = mag * sinf(li * dt);
            const float den = lr * lr + li * li, nr = are - 1.0f;
            const float cre = (nr * lr + aim * li) / den, cim = (aim * lr - nr * li) / den;
            for (int h = 0; h < 16; ++h) { const float br = p.in[10][(g * 64 + pi) * 16 + h], bi = p.in[11][(g * 64 + pi) * 16 + h];
                BB[(pi * 16 + h) * 2] = cre * br - cim * bi; BB[(pi * 16 + h) * 2 + 1] = cre * bi + cim * br; }
            float pr = 1.f, pim = 0.f;
            for (int k = 0; k <= 32; ++k) { AP[(k * 64 + pi) * 2] = pr; AP[(k * 64 + pi) * 2 + 1] = pim; const float t0 = pr * are - pim * aim, t1 = pr * aim + pim * are; pr = t0; pim = t1; }
        }
        for (int e = c.tid; e < 1024; e += NTHR) { const int h = e >> 6, pi = e & 63; CC[e * 2] = p.in[12][(g * 16 + h) * 64 + pi]; CC[e * 2 + 1] = p.in[13][(g * 16 + h) * 64 + pi]; }
        if (c.tid < 16) DD[c.tid] = p.in[14][g * 16 + c.tid];
        __syncthreads();
        if (r == 0 && c.tid < 64) { A32[(g * 64 + c.tid) * 2] = AP[(32 * 64 + c.tid) * 2]; A32[(g * 64 + c.tid) * 2 + 1] = AP[(32 * 64 + c.tid) * 2 + 1]; }
        for (int e = c.tid; e < 1024; e += NTHR) {
            const int lag = 4 * r + (e >> 8), ho = (e >> 4) & 15, hi = e & 15; float s = 0.f;
            for (int pi = 0; pi < 64; ++pi) {
                const float ar = AP[(lag * 64 + pi) * 2], ai = AP[(lag * 64 + pi) * 2 + 1], br = BB[(pi * 16 + hi) * 2], bi = BB[(pi * 16 + hi) * 2 + 1];
                const float wre = ar * br - ai * bi, wim = ar * bi + ai * br;
                s += CC[(ho * 64 + pi) * 2] * wre - CC[(ho * 64 + pi) * 2 + 1] * wim;
            }
            if (lag == 0 && ho == hi) s += DD[ho];
            KTAB[(size_t)(g * 32 + lag) * 256 + ho * 16 + hi] = s;
        }
        for (int e = c.tid; e < 8192; e += NTHR) {
            const int row = 16 * r + (e >> 9), k = e & 511, pi = row & 63, s = k >> 4, hi = k & 15;
            const float ar = AP[((31 - s) * 64 + pi) * 2], ai = AP[((31 - s) * 64 + pi) * 2 + 1], br = BB[(pi * 16 + hi) * 2], bi = BB[(pi * 16 + hi) * 2 + 1];
            const float v = (row < 64) ? (ar * br - ai * bi) : (ar * bi + ai * br);
            M1[((size_t)g * 128 + row) * 512 + k] = (bf16_t)(cvt_pk_bf16(v, 0.f) & 0xffffu);
        }
        for (int e = c.tid; e < 8192; e += NTHR) {
            const int rl = e >> 7, q = e & 127, t = 4 * r + (rl >> 4), ho = rl & 15, pi = q & 63;
            const float ar = AP[((t + 1) * 64 + pi) * 2], ai = AP[((t + 1) * 64 + pi) * 2 + 1], cr = CC[(ho * 64 + pi) * 2], ci = CC[(ho * 64 + pi) * 2 + 1];
            const float v = (q < 64) ? (cr * ar - ci * ai) : -(cr * ai + ci * ar);
            TOEP[((size_t)g * 512 + t * 16 + ho) * XGW + 512 + q] = (bf16_t)(cvt_pk_bf16(v, 0.f) & 0xffffu);
        }
    }
    __syncthreads();
}
__device__ __forceinline__ void p0_wm(const Ctx& c, const float* wsp, bf16_t* WM) {
    for (int e = c.bx * NTHR + c.tid; e < 8 * 128 * 128; e += c.G * NTHR) {
        const int i = (e >> 7) & 127, j = e & 127; const float v = ((j >> 6) <= (i >> 6)) ? wsp[e] : 0.f;
        WM[e] = (bf16_t)(cvt_pk_bf16(v, 0.f) & 0xffffu);
    }
}
__device__ __forceinline__ void p2_gmlp_mix(const Ctx& c, const Params& p, int nb0, int nbstride) {
    unsigned char* ws = p.ws;
    const bf16_t* U = (const bf16_t*)(ws + WS_R1); const bf16_t* V = (const bf16_t*)(ws + WS_R2); bf16_t* YA = (bf16_t*)(ws + WS_R0);
    const float* VSTAT = (const float*)(ws + WS_VSTAT); const bf16_t* WM = (const bf16_t*)(ws + WS_WM);
    const float* lng = p.in[3]; const float* lnb = p.in[4]; const float* bs = p.in[6];
    LAS float* MU = (LAS float*)(c.lds + 2 * 128 * 272);
    const int fr = c.lane & 15, fq = c.lane >> 4, wi = c.wave >> 1, wj = c.wave & 1;
    const int c8 = c.tid & 15, jb = c.tid >> 4;
    for (int nb = nb0; nb < 256; nb += nbstride) {
        const int tok0 = nb * 128;
        u32x4 vr[4];
#pragma unroll
        for (int e = 0; e < 4; ++e) vr[e] = *(const u32x4*)(V + (size_t)(tok0 + jb + 32 * e) * DM + c8 * 8);
        __syncthreads();
        if (c.tid < 128) {
            const f32x4* sp = (const f32x4*)(VSTAT + (size_t)(tok0 + c.tid) * 32); float s = 0.f, q = 0.f;
#pragma unroll
            for (int i = 0; i < 8; ++i) { const f32x4 w = sp[i]; s += w[0] + w[2]; q += w[1] + w[3]; }
            const float mu = s * (1.0f / DM), var = fmaxf(q * (1.0f / DM) - mu * mu, 0.f);
            MU[c.tid] = mu; MU[128 + c.tid] = 1.0f / sqrtf(var + EPSV);
        }
        __syncthreads();
        float mu4[4], rs4[4];
#pragma unroll
        for (int e = 0; e < 4; ++e) { mu4[e] = MU[jb + 32 * e]; rs4[e] = MU[128 + jb + 32 * e]; }
        for (int g = 0; g < 8; ++g) {
            LAS bf16_t* VT = (LAS bf16_t*)(c.lds + (g & 1) * 128 * 272);
            { const int ch = g * 128 + c8 * 8;
                const f32x4 g0 = *(const f32x4*)(lng + ch), g1 = *(const f32x4*)(lng + ch + 4), b0 = *(const f32x4*)(lnb + ch), b1 = *(const f32x4*)(lnb + ch + 4);
#pragma unroll
                for (int e = 0; e < 4; ++e) {
                    const int j = jb + 32 * e; float v[8]; unpack8(vr[e], v);
#pragma unroll
                    for (int i = 0; i < 8; ++i) { const float vn = (v[i] - mu4[e]) * rs4[e] * (i < 4 ? g0[i & 3] : g1[i & 3]) + (i < 4 ? b0[i & 3] : b1[i & 3]);
                        VT[(c8 * 8 + i) * 136 + j] = (bf16_t)(cvt_pk_bf16(vn, 0.f) & 0xffffu); }
                }
            }
            if (g < 7) {
#pragma unroll
                for (int e = 0; e < 4; ++e) vr[e] = *(const u32x4*)(V + (size_t)(tok0 + jb + 32 * e) * DM + (g + 1) * 128 + c8 * 8);
            }
            u32x2 uu[2][4]; float bsv[2];
#pragma unroll
            for (int mf = 0; mf < 2; ++mf) { const int i = 32 * wi + 16 * mf + fr; bsv[mf] = bs[g * 128 + i];
#pragma unroll
                for (int nf = 0; nf < 4; ++nf) uu[mf][nf] = *(const u32x2*)(U + (size_t)(tok0 + i) * DM + g * 128 + 64 * wj + 16 * nf + 4 * fq); }
            bf16x8 af[4][2];
#pragma unroll
            for (int kk = 0; kk < 4; ++kk)
#pragma unroll
                for (int mf = 0; mf < 2; ++mf) af[kk][mf] = *(const bf16x8*)(WM + ((size_t)g * 128 + 32 * wi + 16 * mf + fr) * 128 + 32 * kk + 8 * fq);
            __syncthreads();
            f32x4 acc[2][4];
#pragma unroll
            for (int a = 0; a < 2; ++a)
#pragma unroll
                for (int b = 0; b < 4; ++b) acc[a][b] = (f32x4){0.f, 0.f, 0.f, 0.f};
#pragma unroll
            for (int kk = 0; kk < 4; ++kk) {
                bf16x8 bfr[4];
#pragma unroll
                for (int nf = 0; nf < 4; ++nf) bfr[nf] = *(const LAS bf16x8*)(VT + (64 * wj + 16 * nf + fr) * 136 + 32 * kk + 8 * fq);
#pragma unroll
                for (int mf = 0; mf < 2; ++mf)
#pragma unroll
                    for (int nf = 0; nf < 4; ++nf) acc[mf][nf] = __builtin_amdgcn_mfma_f32_16x16x32_bf16(bfr[nf], af[kk][mf], acc[mf][nf], 0, 0, 0);
            }
#pragma unroll
            for (int mf = 0; mf < 2; ++mf) {
                const int i = 32 * wi + 16 * mf + fr;
#pragma unroll
                for (int nf = 0; nf < 4; ++nf) {
                    const size_t off = (size_t)(tok0 + i) * DM + g * 128 + 64 * wj + 16 * nf + 4 * fq; const u32x2 w = uu[mf][nf];
                    const f32x2 ga = gelu2((f32x2){bf_lo(w[0]), bf_hi(w[0])}), gb = gelu2((f32x2){bf_lo(w[1]), bf_hi(w[1])});
                    const float o0 = ga.x * (acc[mf][nf][0] + bsv[mf]), o1 = ga.y * (acc[mf][nf][1] + bsv[mf]), o2 = gb.x * (acc[mf][nf][2] + bsv[mf]), o3 = gb.y * (acc[mf][nf][3] + bsv[mf]);
                    *(u32x2*)(YA + off) = (u32x2){cvt_pk_bf16(o0, o1), cvt_pk_bf16(o2, o3)};
                }
            }
        }
    }
    __syncthreads();
}
__device__ __forceinline__ void p2_toeplitz(const Ctx& c, const Params& p) {
    const float* KTAB = (const float*)(p.ws + WS_KTAB); bf16_t* TOEP = (bf16_t*)(p.ws + WS_TOEP);
    for (int item = c.bx; item < 256; item += c.G) {
        const int g = item >> 3, r = item & 7;
#pragma unroll
        for (int e = 0; e < 8; ++e) {
            const int idx = c.tid + NTHR * e; const int rl = idx >> 6, c8 = idx & 63;
            const int t = 4 * r + (rl >> 4), ho = rl & 15, s = c8 >> 1, hi0 = (c8 & 1) * 8;
            u32x4 o = (u32x4){0u, 0u, 0u, 0u};
            if (s <= t) { const float* kp = KTAB + (size_t)(g * 32 + (t - s)) * 256 + ho * 16 + hi0; const f32x4 k0 = *(const f32x4*)kp, k1 = *(const f32x4*)(kp + 4);
                o = (u32x4){cvt_pk_bf16(k0[0], k0[1]), cvt_pk_bf16(k0[2], k0[3]), cvt_pk_bf16(k1[0], k1[1]), cvt_pk_bf16(k1[2], k1[3])}; }
            *(u32x4*)(TOEP + ((size_t)g * 512 + t * 16 + ho) * XGW + s * 16 + hi0) = o;
        }
    }
}
__device__ __forceinline__ void s5_scan_item(const Ctx& c, const Params& p, int item) {
    const float* S = (const float*)(p.ws + WS_S); const float* A32 = (const float*)(p.ws + WS_A32); bf16_t* XGE = (bf16_t*)(p.ws + WS_XGE);
    LAS float* L = (LAS float*)c.lds;
    int tid = c.tid; asm volatile("" : "+v"(tid));
    const int g = item >> 2, b = item & 3; const size_t row0 = (size_t)g * NCH + b * NCHB;
    __syncthreads();
    const f32x4* src = (const f32x4*)(S + row0 * 128);
#pragma unroll
    for (int e = 0; e < 16; ++e) { const int idx = tid + NTHR * e; *(LAS f32x4*)(L + idx * 4) = src[idx]; }
    __syncthreads();
    if (tid < 64) {
        const int pi = tid; const float ar = A32[(g * 64 + pi) * 2], ai = A32[(g * 64 + pi) * 2 + 1]; float hr = 0.f, him = 0.f;
        bf16_t* dst = XGE + row0 * XGW + 512 + pi;
#pragma unroll 8
        for (int ch = 0; ch < NCHB; ++ch) {
            const float sr = L[ch * 128 + pi], si = L[ch * 128 + 64 + pi];
            const unsigned w = cvt_pk_bf16(hr, him);
            dst[(size_t)ch * XGW] = (bf16_t)(w & 0xffffu); dst[(size_t)ch * XGW + 64] = (bf16_t)(w >> 16);
            const float t0 = ar * hr - ai * him + sr, t1 = ar * him + ai * hr + si; hr = t0; him = t1;
        }
    }
    asm volatile("s_waitcnt vmcnt(0)" ::: "memory");
    __syncthreads();
}
__device__ __forceinline__ void p10_final_norm(const Ctx& c, const Params& p) {
    const float* PART = (const float*)(p.ws + WS_RSFP); const float* gf = p.in[24]; float* out = p.out; const bf16_t* X2 = (const bf16_t*)(p.ws + WS_R4);
    f32x4 gv[2][2];
#pragma unroll
    for (int j = 0; j < 2; ++j) { gv[j][0] = *(const f32x4*)(gf + j * 512 + c.lane * 8); gv[j][1] = *(const f32x4*)(gf + j * 512 + c.lane * 8 + 4); }
    for (int row = c.bx * 8 + c.wave; row < T_TOK; row += c.G * 8) {
        const f32x4* pp = (const f32x4*)(PART + (size_t)row * 16); const f32x4 p0 = pp[0], p1 = pp[1], p2 = pp[2], p3 = pp[3];
        const u32x4 w0 = *(const u32x4*)(X2 + (size_t)row * DM + c.lane * 8), w1 = *(const u32x4*)(X2 + (size_t)row * DM + 512 + c.lane * 8);
        const float ss = ((p0[0] + p0[1]) + (p0[2] + p0[3])) + ((p1[0] + p1[1]) + (p1[2] + p1[3])) + ((p2[0] + p2[1]) + (p2[2] + p2[3])) + ((p3[0] + p3[1]) + (p3[2] + p3[3]));
        const float rs = 1.0f / sqrtf(ss * (1.0f / DM) + EPSV);
        float* xr = out + (size_t)row * DM;
        float a[8], b[8]; unpack8(w0, a); unpack8(w1, b);
        __builtin_nontemporal_store((f32x4){a[0], a[1], a[2], a[3]} * rs * gv[0][0], (f32x4*)(xr + c.lane * 8));
        __builtin_nontemporal_store((f32x4){a[4], a[5], a[6], a[7]} * rs * gv[0][1], (f32x4*)(xr + c.lane * 8 + 4));
        __builtin_nontemporal_store((f32x4){b[0], b[1], b[2], b[3]} * rs * gv[1][0], (f32x4*)(xr + 512 + c.lane * 8));
        __builtin_nontemporal_store((f32x4){b[4], b[5], b[6], b[7]} * rs * gv[1][1], (f32x4*)(xr + 512 + c.lane * 8 + 4));
    }
}

__global__ void __launch_bounds__(NTHR, 2) hybrid_fwd(Params p) {
    extern __shared__ __attribute__((aligned(16))) unsigned char shm[];
    Ctx c; c.lds = (LAS unsigned char*)shm; c.tid = threadIdx.x; c.lane = c.tid & 63; c.wave = __builtin_amdgcn_readfirstlane(c.tid >> 6); c.G = gridDim.x; c.bx = blockIdx.x;
    unsigned char* ws = p.ws;
    const int lo = p.ph_lo, hi = p.ph_hi;
#ifndef MK_ONLYPH
#define MK_ONLYPH -1
#endif
#define IN(k) ((MK_ONLYPH) < 0 ? (lo <= (k) && (k) < hi) : ((k) == (MK_ONLYPH)))
    if (c.tid < 4) ((LAS unsigned*)(c.lds + LDS_STAGE))[c.tid] = 0u;
    __syncthreads();
    XcdBarrier bar = xcd_barrier_post((unsigned*)(ws + WS_BAR), (volatile LAS unsigned*)(c.lds + LDS_STAGE));
    if (p.ph_hi > 1000) cg::this_grid().sync();
#define GSYNC() xcd_barrier(bar)
#define SEAM(k) do { if (IN(k) && IN((k) + 1)) GSYNC(); } while (0)
#define REP(k) for (int _r = 0; _r < ((MK_REPEAT) == (k) ? 2 : 1); ++_r)
#define REPSYNC(k) do { if ((MK_REPEAT) == (k) && _r == 0) GSYNC(); } while (0)
    bf16_t* R0 = (bf16_t*)(ws + WS_R0); bf16_t* R1 = (bf16_t*)(ws + WS_R1); bf16_t* R2 = (bf16_t*)(ws + WS_R2); bf16_t* R3 = (bf16_t*)(ws + WS_R3); bf16_t* R4 = (bf16_t*)(ws + WS_R4);
    bf16_t* XGE = (bf16_t*)(ws + WS_XGE); bf16_t* YB0 = (bf16_t*)p.out; bf16_t* YB = YB0 + (size_t)T_TOK * S5W;
    if (IN(0)) REP(0) {
        if (c.bx & 8) {
            p0_s5_tables(c, p);
            p0_wm(c, p.in[5], (bf16_t*)(ws + WS_WM));
            p0_convert_x(c, p.in[0], (bf16_t*)(ws + WS_XB), (float*)(ws + WS_RSTD1));
            p0_weights(c, p, 0, 288, 0, c.G);
        } else {
            p0_convert_x(c, p.in[0], (bf16_t*)(ws + WS_XB), (float*)(ws + WS_RSTD1));
            p0_weights(c, p, 0, 288, 0, c.G);
            p0_s5_tables(c, p);
            p0_wm(c, p.in[5], (bf16_t*)(ws + WS_WM));
        }
        REPSYNC(0);
    }
    SEAM(0);
    if (IN(1)) REP(1) {
        p2_toeplitz(c, p);
        pg8::Gemm g{(const bf16_t*)(ws + WS_XB), (const bf16_t*)(ws + WS_WIN), DM, DM, DM}; pg8::StaticOrder S; S.init(T_TOK, INW, c.G, c.bx, MK_WGM_BIG);
        EpiProj E{(const float*)(ws + WS_RSTD1), R1, R2, (float*)(ws + WS_VSTAT), XGE, R3, R4};
        pg8::gemm_phase(c.lds, g, S, E);
        REPSYNC(1);
    }
    SEAM(1);
    if (IN(2)) {
        const int nc = (c.G >= 256) ? 128 : (c.G > 1 ? c.G / 2 : 1), ng = c.G - nc;
        constexpr int NW1 = 704;
        if (c.bx < nc || ng <= 0) {
#pragma nounroll
            for (int pm = __builtin_amdgcn_readfirstlane(c.bx); pm < 128; pm += nc) {
                { pg8::Gemm g{XGE, (const bf16_t*)(ws + WS_M1), 512, XGW, 512}; pg8::OneStateUnit S{pm}; EpiState E{(float*)(ws + WS_S)}; pg8::gemm_phase(c.lds, g, S, E); }
                s5_scan_item(c, p, pm);
                { pg8::Gemm g{XGE, (const bf16_t*)(ws + WS_TOEP), XGW, XGW, XGW}; pg8::PanelPair S{pm}; EpiS5Out E{YB0}; pg8::gemm_phase(c.lds, g, S, E); }
            }
            if (ng > 0) p0_weights(c, p, 288, 288 + NW1, 0, nc); else { p0_weights(c, p, 288, 992, 0, nc); p2_gmlp_mix(c, p, c.bx, nc); }
        } else {
            p0_weights(c, p, 288 + NW1, 992, nc, ng);
            p2_gmlp_mix(c, p, c.bx - nc, ng);
        }
    }
    do { if (IN(2) && IN(5)) GSYNC(); } while (0);
    if (IN(5)) REP(5) {
        pg8::Gemm g{YB0, (const bf16_t*)(ws + WS_WGLU), S5W, S5W, S5W}; pg8::StaticOrder S; S.init(T_TOK, S5W, c.G, c.bx); EpiGlu E{YB0, YB, p.in[16], DM};
        pg8::gemm_phase(c.lds, g, S, E);
        REPSYNC(5);
    }
    SEAM(5);
    if (IN(6)) {
        pg8::SegOrder S; S.S.init(T_TOK, DM, c.G, c.bx); S.a0 = (const char*)YB; S.b0 = (const char*)(ws + WS_PB); S.a1 = (const char*)R0; S.b1 = (const char*)(ws + WS_PA); S.pitch = (size_t)DM * 2;
        pg8::Gemm g{nullptr, nullptr, DM, DM, DM}; EpiMergeSeg E{R3, R4, R1};
        pg8::gemm_phase<1, true>(c.lds, g, S, E);
    }
    SEAM(6);
    if (IN(7)) REP(7) {
        pg8::Gemm g{R1, (const bf16_t*)(ws + WS_WOUT), DM, DM, DM}; pg8::StaticOrder S; S.init(T_TOK, DM, c.G, c.bx);
        EpiResid<2> E{ws + WS_XB, R0, (float*)(ws + WS_RS2P), (const float*)(ws + WS_RSTD1)};
        pg8::gemm_phase(c.lds, g, S, E);
        REPSYNC(7);
    }
    SEAM(7);
    if (IN(8)) REP(8) {
        pg8::Gemm g{R0, (const bf16_t*)(ws + WS_WGU), DM, DM, DM}; pg8::StaticOrder S; S.init(T_TOK, 2 * FFH, c.G, c.bx, MK_WGM_BIG);
        LAS float* RSL = (LAS float*)(c.lds + LDS_RSTD);
        {
            const float* PART = (const float*)(ws + WS_RS2P); pg8::Unit u;
            for (int i = 0; i < 12 && S.next(i, u); ++i)
                if (c.tid < 256) { const f32x4* pp = (const f32x4*)(PART + (size_t)(u.pm * 256 + c.tid) * 16); const f32x4 p0 = pp[0], p1 = pp[1], p2 = pp[2], p3 = pp[3];
                    const float ss = ((p0[0] + p0[1]) + (p0[2] + p0[3])) + ((p1[0] + p1[1]) + (p1[2] + p1[3])) + ((p2[0] + p2[1]) + (p2[2] + p2[3])) + ((p3[0] + p3[1]) + (p3[2] + p3[3]));
                    RSL[i * 256 + c.tid] = __builtin_amdgcn_rsqf(ss * (1.0f / DM) + EPSV); }
            __syncthreads();
        }
        EpiGateUp E{RSL, R1};
        pg8::gemm_phase<((MK_REPEAT) == 20 ? 2 : ((MK_REPEAT) == 21 ? -1 : 1))>(c.lds, g, S, E);
        REPSYNC(8);
    }
    SEAM(8);
    if (IN(9)) {
        pg8::Gemm g{R1, (const bf16_t*)(ws + WS_WD), FFH, FFH, FFH}; pg8::StaticOrder S; S.init(T_TOK, DM, c.G, c.bx);
        if (c.G == 256) {
            EpiFinal E{R0, p.out, (float*)(ws + WS_RSFP), (unsigned*)(ws + WS_PCNT), p.in[24]};
            pg8::gemm_phase(c.lds, g, S, E);
        } else {
            EpiResid<1> E{R0, R4, (float*)(ws + WS_RSFP), nullptr};
            pg8::gemm_phase(c.lds, g, S, E);
            GSYNC();
            p10_final_norm(c, p);
        }
    }
    if ((MK_REPEAT) == 11) for (int i = 0; i < 8; ++i) GSYNC();
#undef IN
#undef SEAM
}

extern "C" void kernel_launch(void* const* d_in, const int* in_sizes, int n_in, void* d_out, int out_size, void* d_ws, size_t ws_size, hipStream_t stream) {
    static int grid = 0;
    if (grid == 0) {
        if (n_in != 25 || out_size != T_TOK * DM || ws_size < WS_END) { fprintf(stderr, "kernel_launch: unexpected shapes (n_in %d out %d ws %zu)\n", n_in, out_size, ws_size); grid = -1; return; }
        int dev = 0, cus = 0, per_cu = 0;
        hipGetDevice(&dev); hipDeviceGetAttribute(&cus, hipDeviceAttributeMultiprocessorCount, dev);
        if (hipFuncSetAttribute((const void*)hybrid_fwd, hipFuncAttributeMaxDynamicSharedMemorySize, LDS_BYTES) != hipSuccess) { fprintf(stderr, "kernel_launch: hipFuncSetAttribute failed\n"); grid = -1; return; }
        if (hipOccupancyMaxActiveBlocksPerMultiprocessor(&per_cu, (const void*)hybrid_fwd, NTHR, LDS_BYTES) != hipSuccess || per_cu < 1) { fprintf(stderr, "kernel_launch: occupancy query gave %d\n", per_cu); per_cu = 1; }
        (void)hipGetLastError();
        grid = cus;
    }
    if (grid < 0) return;
    Params p{};
    for (int i = 0; i < 25; ++i) p.in[i] = (const float*)d_in[i];
    p.out = (float*)d_out; p.ws = (unsigned char*)d_ws;
    (void)hipMemsetAsync((unsigned char*)d_ws + WS_BAR, 0, 16384 + 128 * 256, stream);
#if MK_PER_PHASE
    for (int ph = 0; ph <= 10; ++ph) { p.ph_lo = ph; p.ph_hi = ph + 1; hipLaunchKernelGGL(hybrid_fwd, dim3(grid), dim3(NTHR), LDS_BYTES, stream, p); }
#else
    p.ph_lo = 0; p.ph_hi = 11;
    void* args[] = {&p};
    hipError_t e = hipLaunchCooperativeKernel((const void*)hybrid_fwd, dim3(grid), dim3(NTHR), args, LDS_BYTES, stream);
    if (e != hipSuccess) fprintf(stderr, "cooperative launch failed: %s (grid %d)\n", hipGetErrorString(e), grid);
#endif
}
```

```cpp
#include <hip/hip_runtime.h>
#include <hip/hip_cooperative_groups.h>
#include <cstdio>
namespace cg = cooperative_groups;

#ifndef MK_PER_PHASE
#define MK_PER_PHASE 0
#endif

#ifndef MK_WGM_BIG
#define MK_WGM_BIG 4
#endif
#ifndef MK_REPEAT
#define MK_REPEAT -1
#endif
#define LAS __attribute__((address_space(3)))
typedef unsigned short bf16_t;
typedef short bf16x8 __attribute__((ext_vector_type(8)));
typedef float f32x4 __attribute__((ext_vector_type(4)));
typedef float f32x2 __attribute__((ext_vector_type(2)));
typedef unsigned u32x4 __attribute__((ext_vector_type(4)));
typedef unsigned u32x2 __attribute__((ext_vector_type(2)));

constexpr int T_TOK = 32768, DM = 1024, INW = 4608, FFH = 2816, S5W = 512, S5G = 32, S5P = 64, S5H = 16;
constexpr int TC = 32;
constexpr int NCHB = 8192 / TC;
constexpr int NCH = T_TOK / TC;
constexpr int XGW = TC * S5H + 2 * S5P;
constexpr float EPSV = 1e-6f;
constexpr int NTHR = 512;
constexpr int LDS_STAGE = 131072;
constexpr int LDS_RSTD = LDS_STAGE + 16;
constexpr int LDS_BYTES = LDS_RSTD + 12 * 256 * 4;

constexpr size_t MiB = 1048576;
constexpr size_t WS_R0 = 0 * MiB;
constexpr size_t WS_R1 = 64 * MiB;
constexpr size_t WS_R2 = 128 * MiB;
constexpr size_t WS_R3 = 192 * MiB;
constexpr size_t WS_R4 = 256 * MiB;
constexpr size_t WS_XGE = 320 * MiB;
constexpr size_t WS_TOEP = 360 * MiB;
constexpr size_t WS_M1 = 380 * MiB;
constexpr size_t WS_S = 385 * MiB;
constexpr size_t WS_WIN = 401 * MiB;
constexpr size_t WS_WGLU = 410 * MiB;
constexpr size_t WS_PA = 411 * MiB;
constexpr size_t WS_PB = 439 * MiB;
constexpr size_t WS_WOUT = 414 * MiB;
constexpr size_t WS_WGU = 416 * MiB;
constexpr size_t WS_WD = 427 * MiB;
constexpr size_t WS_VSTAT = 433 * MiB;
constexpr size_t WS_RS2P = 437 * MiB;
constexpr size_t WS_RSFP = 439 * MiB;
constexpr size_t WS_RSTD1 = 441 * MiB;
constexpr size_t WS_KTAB = 442 * MiB;
constexpr size_t WS_A32 = 443 * MiB;
constexpr size_t WS_WM = 444 * MiB;
constexpr size_t WS_BAR = 446 * MiB;
constexpr size_t WS_PCNT = WS_BAR + 16384;
constexpr size_t WS_XB = 447 * MiB;
constexpr size_t WS_END = 511 * MiB;

struct Params { const float* in[25]; float* out; unsigned char* ws; int ph_lo, ph_hi; };

typedef __bf16 bf16x2_t __attribute__((ext_vector_type(2)));
__device__ __forceinline__ unsigned cvt_pk_bf16(float lo, float hi) { const f32x2 f = {lo, hi}; const bf16x2_t b = __builtin_convertvector(f, bf16x2_t); return __builtin_bit_cast(unsigned, b); }
__device__ __forceinline__ float bf_lo(unsigned w) { return __uint_as_float(w << 16); }
__device__ __forceinline__ float bf_hi(unsigned w) { return __uint_as_float(w & 0xffff0000u); }
__device__ __forceinline__ float sigmoid_f(float x) { return __builtin_amdgcn_rcpf(1.0f + __builtin_amdgcn_exp2f(-1.442695041f * x)); }
__device__ __forceinline__ float gelu_t(float x) {
    const float z = x * (0.7978845608f + 0.0356774081f * x * x);
    return x * __builtin_amdgcn_rcpf(1.0f + __builtin_amdgcn_exp2f(-2.885390082f * z));
}
__device__ __forceinline__ float silu_f(float x) { return x * sigmoid_f(x); }
__device__ __forceinline__ f32x2 gelu2(f32x2 x) {
    const f32x2 t = x * ((x * x) * (-0.1029432397f) + (-2.302208198f));
    f32x2 e; e.x = __builtin_amdgcn_exp2f(t.x); e.y = __builtin_amdgcn_exp2f(t.y);
    const f32x2 d = e + 1.0f;
    f32x2 r; r.x = __builtin_amdgcn_rcpf(d.x); r.y = __builtin_amdgcn_rcpf(d.y);
    return x * r;
}
__device__ __forceinline__ void gelu8(float (&v)[8]) {
#pragma unroll
    for (int i = 0; i < 8; i += 2) { const f32x2 g = gelu2((f32x2){v[i], v[i + 1]}); v[i] = g.x; v[i + 1] = g.y; }
}
__device__ __forceinline__ u32x4 pack8(const float (&v)[8]) { u32x4 r; r[0] = cvt_pk_bf16(v[0], v[1]); r[1] = cvt_pk_bf16(v[2], v[3]); r[2] = cvt_pk_bf16(v[4], v[5]); r[3] = cvt_pk_bf16(v[6], v[7]); return r; }
__device__ __forceinline__ void unpack8(const u32x4 w, float (&v)[8]) {
#pragma unroll
    for (int i = 0; i < 4; ++i) { v[2 * i] = bf_lo(w[i]); v[2 * i + 1] = bf_hi(w[i]); }
}


#define XB_TMO      128
#define XB_XCNT(j)  (256  + 64 * (j))
#define XB_XSUB(j)  (1280 + 64 * (j))
#define XB_XGEN(j)  (2304 + 64 * (j))
#define XB_TOP      3328
#define XB_TOPGEN   3392
#define XCD_BAR_WORDS 3456
#define XB_SPIN_CAP (1u << 22)
__device__ __forceinline__ unsigned xb_ld(unsigned* p)              { return __hip_atomic_load(p, __ATOMIC_RELAXED, __HIP_MEMORY_SCOPE_AGENT); }
__device__ __forceinline__ unsigned xb_add(unsigned* p, unsigned v) { return __hip_atomic_fetch_add(p, v, __ATOMIC_RELAXED, __HIP_MEMORY_SCOPE_AGENT); }
__device__ __forceinline__ unsigned xb_xcc_id() { return (unsigned)__builtin_amdgcn_s_getreg((3 << 11) | 20) & 0xFu; }
#define XB_SPIN(cond, bar) do { unsigned _sp = 0; while (cond) { __builtin_amdgcn_s_sleep(1); \
    if ((++_sp & 255u) == 0u) { if (xb_ld(&(bar)[XB_TMO])) break; if (_sp > XB_SPIN_CAP) { atomicAdd(&(bar)[XB_TMO], 1u); break; } } } } while (0)
struct XcdBarrier { unsigned* bar; unsigned x; volatile LAS unsigned* st; };
__device__ __forceinline__ XcdBarrier xcd_barrier_post(unsigned* bar, volatile LAS unsigned* st) {
    XcdBarrier b; b.bar = bar; b.x = xb_xcc_id(); b.st = st;
    if (threadIdx.x == 0) (void)xb_add(&bar[XB_XCNT(b.x)], 1u);
    return b;
}
__device__ __forceinline__ void xcd_barrier_complete(unsigned* bar, unsigned x, unsigned& nloc, unsigned& nx) {
    const unsigned G = gridDim.x * gridDim.y * gridDim.z;
    unsigned sum, cnt, mine, sp = 0u;
    for (;;) {
        sum = 0u; cnt = 0u; mine = 0u;
#pragma unroll
        for (unsigned j = 0; j < 16; ++j) { const unsigned c = xb_ld(&bar[XB_XCNT(j)]); sum += c; cnt += (c > 0u) ? 1u : 0u; mine = (j == x) ? c : mine; }
        if (sum == G) break;
        __builtin_amdgcn_s_sleep(1);
        if ((++sp & 255u) == 0u) { if (xb_ld(&bar[XB_TMO])) break; if (sp > XB_SPIN_CAP) { atomicAdd(&bar[XB_TMO], 1u); break; } }
    }
    nloc = mine > 0u ? mine : 1u; nx = cnt > 0u ? cnt : 1u;
}
__device__ __forceinline__ void xcd_barrier(const XcdBarrier& b) {
    asm volatile("s_waitcnt vmcnt(0)" ::: "memory");
    __syncthreads();
    if (threadIdx.x == 0) {
        unsigned* bar = b.bar;
        __builtin_amdgcn_s_waitcnt(0);
        unsigned nloc = b.st[0], nx = b.st[1];
        if (nloc == 0u) { xcd_barrier_complete(bar, b.x, nloc, nx); b.st[0] = nloc; b.st[1] = nx; }
        const unsigned old = xb_add(&bar[XB_XSUB(b.x)], 1u);
        const unsigned gen = old / nloc;
        if (old + 1u == (gen + 1u) * nloc) {
            __builtin_amdgcn_fence(__ATOMIC_RELEASE, "agent");
            asm volatile("s_waitcnt vmcnt(0)" ::: "memory");
            const unsigned og = xb_add(&bar[XB_TOP], 1u);
            const unsigned tg = og / nx;
            if (og + 1u == (tg + 1u) * nx) xb_add(&bar[XB_TOPGEN], 1u);
            else XB_SPIN(xb_ld(&bar[XB_TOPGEN]) == tg, bar);
            __builtin_amdgcn_fence(__ATOMIC_ACQUIRE, "agent");
            xb_add(&bar[XB_XGEN(b.x)], 1u);
            asm volatile("s_waitcnt vmcnt(0)" ::: "memory");
        } else {
            XB_SPIN(xb_ld(&bar[XB_XGEN(b.x)]) == gen, bar);
            __builtin_amdgcn_fence(__ATOMIC_ACQUIRE, "agent");
            asm volatile("s_waitcnt vmcnt(0)" ::: "memory");
        }
    }
    __syncthreads();
}

namespace pg8 {
constexpr int BM = 256, BK = 64, HALF = 128, HTB = HALF * BK * 2, STAGE_BYTES = 8 * HTB, NXCD = 8, WGM = 8;
__host__ __device__ __forceinline__ int lds_byte(int r, int c) { const int st = (r >> 4) * 2 + (c >> 5), rr = r & 15, cc = c & 31, ob = rr * 64 + cc * 2; return st * 1024 + (ob ^ (((ob >> 9) & 1) << 5)); }
__host__ __device__ __forceinline__ void stage_rc(int b, int& R, int& C) { const int st = b / 1024, sb = b % 1024, swz = sb ^ (((sb >> 9) & 1) << 5); R = (st >> 1) * 16 + swz / 64; C = (st & 1) * 32 + (swz % 64) / 2; }
__host__ __device__ __forceinline__ int perm32(int rho) { const int n = rho >> 4, i = rho & 15; return 8 * (i >> 2) + 4 * n + (i & 3); }

struct Unit { int pm, pn, ra, rb, idx; const char* pa; const char* pb; int nt, kind; };
struct Gemm { const bf16_t* A; const bf16_t* Bt; int K, lda, ldb; };

struct StaticOrder {
    int nM, nN, nwg, G, c, wgm;
    __device__ void init(int M, int N, int G_, int c_, int wgm_ = WGM) { nM = M / BM; nN = N / BM; nwg = nM * nN; G = G_; c = c_; wgm = wgm_; }
    __device__ bool next(int i, Unit& u) const {
        const long L = (long)i * G + c; if (L >= nwg) return false;
        int wgid = (int)L; { const int q = nwg / NXCD, r = nwg % NXCD, xcd = wgid % NXCD, off = wgid / NXCD; wgid = (xcd < r ? xcd * (q + 1) : r * (q + 1) + (xcd - r) * q) + off; }
        const int nig = wgm * nN, gid = wgid / nig, fm = gid * wgm, gsz = (nM - fm) < wgm ? (nM - fm) : wgm;
        u.pm = fm + ((wgid % nig) % gsz); u.pn = (wgid % nig) / gsz; u.ra = u.pm * BM; u.rb = u.pn * BM; u.idx = i; return true;
    }
};
struct StateOrder {
    int G, c;
    __device__ bool next(int i, Unit& u) const { const int L = i * G + c; if (L >= 128) return false; u.pm = L; u.pn = 0; u.ra = L * BM; u.rb = (L >> 2) * 128; u.idx = i; return true; }
};
struct SegOrder {
    StaticOrder S; const char* a0; const char* b0; const char* a1; const char* b1; size_t pitch;
    __device__ bool next(int j, Unit& u) const {
        if (!S.next(j >> 1, u)) return false;
        u.idx = j; u.kind = j & 1; u.nt = (j & 1) ? 16 : 8;
        u.pa = ((j & 1) ? a1 : a0) + (size_t)u.ra * pitch; u.pb = ((j & 1) ? b1 : b0) + (size_t)u.rb * pitch; return true;
    }
};
struct OneStateUnit { int pm; __device__ bool next(int i, Unit& u) const { if (i > 0) return false; u.pm = pm; u.pn = 0; u.ra = pm * BM; u.rb = (pm >> 2) * 128; u.idx = 0; return true; } };
struct PanelPair { int pm; __device__ bool next(int i, Unit& u) const { if (i > 1) return false; u.pm = pm; u.pn = i; u.ra = pm * BM; u.rb = (pm >> 2) * 512 + i * BM; u.idx = i; return true; } };
struct S5OutOrder {
    int G, c;
    __device__ bool next(int i, Unit& u) const { const int L = i * G + c; if (L >= 256) return false; u.pm = L >> 1; u.pn = L & 1; u.ra = u.pm * BM; u.rb = (u.pm >> 2) * 512 + u.pn * BM; u.idx = i; return true; }
};

template <int KREP = 1, bool SEG = false, class Epi, class Sched>
__device__ __forceinline__ void gemm_phase(LAS unsigned char* lds, const Gemm g, const Sched& S, const Epi& E) {
    const int tid = threadIdx.x, wid = __builtin_amdgcn_readfirstlane(tid >> 6), lane = tid & 63, wr = wid >> 2, wc = wid & 3, fr = lane & 15, fq = lane >> 4;
    const int K = g.K, nt = K / BK;
    unsigned voffA[2], voffB[2];
#pragma unroll
    for (int i = 0; i < 2; ++i) { int R, C; stage_rc(tid * 16 + i * 8192, R, C); const int Rb = (R & ~31) + perm32(R & 31);
        voffA[i] = (unsigned)(R * g.lda + C) * 2u; voffB[i] = (unsigned)(Rb * g.ldb + C) * 2u; }
    const size_t kstep = (size_t)(BK * 2);
    const size_t hsA = (size_t)HALF * g.lda * 2, hsB = (size_t)HALF * g.ldb * 2;
    const size_t rowA = (size_t)g.lda * 2, rowB = (size_t)g.ldb * 2;
    const unsigned ldsw = (unsigned)wid * 1024u;
    const int aoff = lds_byte(wr * 64 + fr, fq * 8), boff = lds_byte(wc * 32 + fr, fq * 8);
#define PG8_SA(b, h) (((b) * 2 + (h)) * HTB)
#define PG8_SB(b, h) ((4 + (b) * 2 + (h)) * HTB)
#define PG8_STAGE(bufoff, gbase, voff) do { _Pragma("unroll") for (int _i = 0; _i < 2; ++_i) \
        __builtin_amdgcn_global_load_lds((const unsigned*)((const char*)(gbase) + (voff)[_i]), (LAS unsigned*)(lds + (bufoff) + ldsw + _i * 8192), 16, 0, 0); } while (0)
#define PG8_LDA(dst, b, h) do { _Pragma("unroll") for (int m = 0; m < 4; ++m) _Pragma("unroll") for (int k = 0; k < 2; ++k) dst[m][k] = *(const LAS bf16x8*)(lds + PG8_SA(b, h) + aoff + m * 2048 + k * 1024); } while (0)
#define PG8_LDB(dst, b, h) do { _Pragma("unroll") for (int n = 0; n < 2; ++n) _Pragma("unroll") for (int k = 0; k < 2; ++k) dst[n][k] = *(const LAS bf16x8*)(lds + PG8_SB(b, h) + boff + n * 2048 + k * 1024); } while (0)
#define PG8_MMA(ai, bj, At, Bt) do { __builtin_amdgcn_s_setprio(1); _Pragma("unroll") for (int m = 0; m < 4; ++m) _Pragma("unroll") for (int n = 0; n < 2; ++n) _Pragma("unroll") for (int k = 0; k < 2; ++k) \
        acc[ai][bj][m][n] = __builtin_amdgcn_mfma_f32_16x16x32_bf16(Bt[n][k], At[m][k], acc[ai][bj][m][n], 0, 0, 0); __builtin_amdgcn_s_setprio(0); } while (0)
#define PG8_WAIT_V(n) asm volatile("s_waitcnt vmcnt(" #n ")" ::: "memory")
#define PG8_WAIT_L(n) asm volatile("s_waitcnt lgkmcnt(" #n ")" ::: "memory")
#define PG8_BAR __builtin_amdgcn_s_barrier()
#define PG8_SCHED __builtin_amdgcn_sched_barrier(0)
    Unit cur, nxt; int ui = 0;
    if (!S.next(0, cur)) return;
    f32x4 acc[2][2][4][2];
#pragma unroll
    for (int a = 0; a < 2; ++a)
#pragma unroll
        for (int b = 0; b < 2; ++b)
#pragma unroll
            for (int m = 0; m < 4; ++m)
#pragma unroll
                for (int n = 0; n < 2; ++n) acc[a][b][m][n] = (f32x4){0.f, 0.f, 0.f, 0.f};
    bf16x8 At[4][2], B0[2][2], B1[2][2];
    const char* cA = SEG ? cur.pa : (const char*)g.A + (size_t)cur.ra * rowA; const char* cB = SEG ? cur.pb : (const char*)g.Bt + (size_t)cur.rb * rowB;
    PG8_STAGE(PG8_SB(0, 0), cB, voffB); PG8_STAGE(PG8_SA(0, 0), cA, voffA); PG8_STAGE(PG8_SB(0, 1), cB + hsB, voffB); PG8_STAGE(PG8_SA(0, 1), cA + hsA, voffA);
    if (wr == 1) PG8_BAR;
    PG8_WAIT_V(4); PG8_BAR;
    PG8_STAGE(PG8_SB(1, 0), cB + kstep, voffB); PG8_STAGE(PG8_SA(1, 0), cA + kstep, voffA); PG8_STAGE(PG8_SB(1, 1), cB + hsB + kstep, voffB);
    PG8_WAIT_V(6); PG8_BAR;
    for (;;) {
        const bool has_next = S.next(ui + 1, nxt);
        const char* nA = has_next ? (SEG ? nxt.pa : (const char*)g.A + (size_t)nxt.ra * rowA) : cA; const char* nB = has_next ? (SEG ? nxt.pb : (const char*)g.Bt + (size_t)nxt.rb * rowB) : cB;
        const int ntu = SEG ? cur.nt : nt;
        for (int kr = 0; kr < (KREP < 1 ? 1 : KREP); ++kr)
        for (int t = 0; t < ntu; t += 2) {
            const bool last = (t == ntu - 2);
            const char* a1 = cA + (size_t)(t + 1) * kstep;
            const char* a2 = last ? ((KREP > 1 && kr + 1 < KREP) ? cA : nA) : cA + (size_t)(t + 2) * kstep; const char* b2 = last ? ((KREP > 1 && kr + 1 < KREP) ? cB : nB) : cB + (size_t)(t + 2) * kstep;
            const char* a3 = a2 + kstep; const char* b3 = b2 + kstep;
            PG8_LDB(B0, 0, 0); PG8_SCHED; PG8_LDA(At, 0, 0); PG8_STAGE(PG8_SA(1, 1), a1 + hsA, voffA);
            PG8_WAIT_L(8); PG8_BAR; PG8_WAIT_L(0); PG8_MMA(0, 0, At, B0); PG8_BAR; PG8_SCHED;
            PG8_LDB(B1, 0, 1); PG8_STAGE(PG8_SB(0, 0), b2, voffB);
            PG8_BAR; PG8_WAIT_L(0); PG8_MMA(0, 1, At, B1); PG8_BAR;
            PG8_LDA(At, 0, 1); PG8_STAGE(PG8_SA(0, 0), a2, voffA);
            PG8_BAR; PG8_WAIT_L(0); PG8_MMA(1, 0, At, B0); PG8_BAR; PG8_SCHED;
            PG8_STAGE(PG8_SB(0, 1), b2 + hsB, voffB);
            PG8_WAIT_V(6); PG8_BAR; PG8_MMA(1, 1, At, B1); PG8_BAR;
            PG8_LDB(B0, 1, 0); PG8_SCHED; PG8_LDA(At, 1, 0); PG8_STAGE(PG8_SA(0, 1), a2 + hsA, voffA);
            PG8_WAIT_L(8); PG8_BAR; PG8_WAIT_L(0); PG8_MMA(0, 0, At, B0); PG8_BAR; PG8_SCHED;
            PG8_LDB(B1, 1, 1); PG8_STAGE(PG8_SB(1, 0), b3, voffB);
            PG8_BAR; PG8_WAIT_L(0); PG8_MMA(0, 1, At, B1); PG8_BAR;
            PG8_LDA(At, 1, 1); PG8_STAGE(PG8_SA(1, 0), a3, voffA);
            PG8_BAR; PG8_WAIT_L(0); PG8_MMA(1, 0, At, B0); PG8_BAR; PG8_SCHED;
            PG8_STAGE(PG8_SB(1, 1), b3 + hsB, voffB);
            PG8_WAIT_V(6); PG8_BAR; PG8_MMA(1, 1, At, B1); PG8_BAR;
        }
        asm volatile("" ::: "memory");
        if (wr == 0) PG8_BAR;
        asm volatile("" ::: "memory");
        E(acc, cur, wr, wc, fr, fq);
        if (KREP < 0) { asm volatile("" ::: "memory"); E(acc, cur, wr, wc, fr, fq); }
        if (!has_next) break;
        if (!(SEG && cur.kind == 0)) {
#pragma unroll
        for (int a = 0; a < 2; ++a)
#pragma unroll
            for (int b = 0; b < 2; ++b)
#pragma unroll
                for (int m = 0; m < 4; ++m)
#pragma unroll
                    for (int n = 0; n < 2; ++n) acc[a][b][m][n] = (f32x4){0.f, 0.f, 0.f, 0.f};
        }
        cur = nxt; cA = nA; cB = nB; ++ui;
        asm volatile("" ::: "memory");
        if (wr == 1) PG8_BAR;
        asm volatile("" ::: "memory");
    }
    PG8_WAIT_V(0);
    PG8_BAR;
#undef PG8_SA
#undef PG8_SB
#undef PG8_STAGE
#undef PG8_LDA
#undef PG8_LDB
#undef PG8_MMA
#undef PG8_WAIT_V
#undef PG8_WAIT_L
#undef PG8_BAR
#undef PG8_SCHED
}
}

typedef f32x4 AccT[2][2][4][2];
#define EPI_ROWS(u) for (int ai = 0; ai < 2; ++ai) for (int m = 0; m < 4; ++m)
#define EPI_LOAD8(v, ai, bj, m) do { _Pragma("unroll") for (int _q = 0; _q < 4; ++_q) { v[_q] = acc[ai][bj][m][0][_q]; v[4 + _q] = acc[ai][bj][m][1][_q]; } } while (0)

struct EpiProj {
    const float* rstd1; bf16_t* U; bf16_t* V; float* VSTAT; bf16_t* XGE; bf16_t* GA; bf16_t* GB;
    template <int KIND> __device__ __forceinline__ void seg(const AccT& acc, const pg8::Unit& u, int wr, int wc, int fr, int fq) const {
        const int row0 = u.pm * 256 + wr * 64 + fr, colb = u.pn * 256 + wc * 32 + 8 * fq;
        bf16_t* const gdst = (u.pn < 14) ? GA : GB; const int gofs = (u.pn < 14) ? 2560 : 3584;
#pragma unroll
        for (int ai = 0; ai < 2; ++ai) {
#pragma unroll
            for (int m = 0; m < 4; ++m) {
                const int row = row0 + ai * 128 + m * 16;
                float s = 0.f, q = 0.f;
#pragma unroll
                for (int bj = 0; bj < 2; ++bj) {
                    const int col = colb + bj * 128; float v[8]; EPI_LOAD8(v, ai, bj, m);
                    if (KIND == 0) {
                        *(u32x4*)(U + (size_t)row * DM + col) = pack8(v);
                    } else if (KIND == 1) {
                        gelu8(v);
#pragma unroll
                        for (int i = 0; i < 8; ++i) { s += v[i]; q += v[i] * v[i]; }
                        *(u32x4*)(V + (size_t)row * DM + (col - 1024)) = pack8(v);
                    } else if (KIND == 2) {
                        const int cl = col - 2048, gg = cl >> 4, hi0 = cl & 15;
                        *(u32x4*)(XGE + ((size_t)gg * NCH + (row >> 5)) * XGW + (row & 31) * 16 + hi0) = pack8(v);
                    } else if (bj == 0) {
                        float w[8]; EPI_LOAD8(w, ai, 1, m);
                        const int oc = (u.pn - 10) * 128 + wc * 32 + 8 * fq;
#pragma unroll
                        for (int i = 0; i < 8; ++i) { const float ea = fminf(__builtin_amdgcn_exp2f(-1.442695041f * v[i]), 1e30f), eb = fminf(__builtin_amdgcn_exp2f(-1.442695041f * w[i]), 1e30f);
                            v[i] = __builtin_amdgcn_rcpf(1.0f + ea); w[i] = (1.0f + ea) * __builtin_amdgcn_rcpf(1.0f + eb); }
                        *(u32x4*)(GA + (size_t)row * DM + oc) = pack8(v);
                        *(u32x4*)(GB + (size_t)row * DM + oc) = pack8(w);
                    }
                }
                if (KIND == 1) {
                    s += __shfl_xor(s, 16); q += __shfl_xor(q, 16); s += __shfl_xor(s, 32); q += __shfl_xor(q, 32);
                    if (fq == 0) *(f32x2*)(VSTAT + ((size_t)row * 16 + (u.pn - 4) * 4 + wc) * 2) = (f32x2){s, q};
                }
            }
        }
    }
    __device__ __forceinline__ void operator()(const AccT& acc, const pg8::Unit& u, int wr, int wc, int fr, int fq) const {
        if (u.pn < 4) seg<0>(acc, u, wr, wc, fr, fq);
        else if (u.pn < 8) seg<1>(acc, u, wr, wc, fr, fq);
        else if (u.pn < 10) seg<2>(acc, u, wr, wc, fr, fq);
        else seg<3>(acc, u, wr, wc, fr, fq);
    }
};
struct EpiState {
    float* S;
    __device__ __forceinline__ void operator()(const AccT& acc, const pg8::Unit& u, int wr, int wc, int fr, int fq) const {
        const int row0 = u.pm * 256 + wr * 64 + fr, col = wc * 32 + 8 * fq;
#pragma unroll
        for (int ai = 0; ai < 2; ++ai)
#pragma unroll
            for (int m = 0; m < 4; ++m) { float* p = S + (size_t)(row0 + ai * 128 + m * 16) * 128 + col; *(f32x4*)p = acc[ai][0][m][0]; *(f32x4*)(p + 4) = acc[ai][0][m][1]; }
    }
};
struct EpiS5Out {
    bf16_t* YB0;
    __device__ __forceinline__ void operator()(const AccT& acc, const pg8::Unit& u, int wr, int wc, int fr, int fq) const {
        const int row0 = u.pm * 256 + wr * 64 + fr, colb = u.pn * 256 + wc * 32 + 8 * fq;
#pragma unroll
        for (int ai = 0; ai < 2; ++ai)
#pragma unroll
            for (int m = 0; m < 4; ++m) {
                const int row = row0 + ai * 128 + m * 16, gg = row >> 10, n = row & 1023;
#pragma unroll
                for (int bj = 0; bj < 2; ++bj) {
                    const int col = colb + bj * 128, t = col >> 4, ho0 = col & 15; float v[8]; EPI_LOAD8(v, ai, bj, m);
                    gelu8(v);
                    *(u32x4*)(YB0 + (size_t)(n * TC + t) * S5W + gg * 16 + ho0) = pack8(v);
                }
            }
    }
};
struct EpiGlu {
    const bf16_t* YB0; bf16_t* YB; const float* bias; int ldy;
    __device__ __forceinline__ void operator()(const AccT& acc, const pg8::Unit& u, int wr, int wc, int fr, int fq) const {
        const int row0 = u.pm * 256 + wr * 64 + fr, colb = u.pn * 256 + wc * 32 + 8 * fq;
        f32x4 bq[2][2];
#pragma unroll
        for (int bj = 0; bj < 2; ++bj) { bq[bj][0] = *(const f32x4*)(bias + colb + bj * 128); bq[bj][1] = *(const f32x4*)(bias + colb + bj * 128 + 4); }
#pragma unroll
        for (int ai = 0; ai < 2; ++ai)
#pragma unroll
            for (int mp = 0; mp < 1; ++mp) {
                u32x4 yv[4][2];
#pragma unroll
                for (int mm = 0; mm < 4; ++mm)
#pragma unroll
                    for (int bj = 0; bj < 2; ++bj) yv[mm][bj] = *(const u32x4*)(YB0 + (size_t)(row0 + ai * 128 + mm * 16) * S5W + colb + bj * 128);
#pragma unroll
                for (int mm = 0; mm < 4; ++mm)
#pragma unroll
                    for (int bj = 0; bj < 2; ++bj) { const int m = mm;
                        float v[8], y[8]; EPI_LOAD8(v, ai, bj, m); unpack8(yv[mm][bj], y);
#pragma unroll
                        for (int i = 0; i < 8; ++i) v[i] = y[i] * sigmoid_f(v[i] + (i < 4 ? bq[bj][0][i & 3] : bq[bj][1][i & 3]));
                        *(u32x4*)(YB + (size_t)(row0 + ai * 128 + m * 16) * ldy + colb + bj * 128) = pack8(v); }
            }
    }
};
template <int ACCUM> struct EpiMerge {
    const bf16_t* GATE; bf16_t* MRG;
    __device__ __forceinline__ void operator()(const AccT& acc, const pg8::Unit& u, int wr, int wc, int fr, int fq) const {
        const int row0 = u.pm * 256 + wr * 64 + fr, colb = u.pn * 256 + wc * 32 + 8 * fq;
        constexpr int NB = ACCUM ? 2 : 4;
#pragma unroll
        for (int ai = 0; ai < 2; ++ai)
#pragma unroll
            for (int mb = 0; mb < 4; mb += NB) {
                u32x4 gv[NB][2], ov[NB][2];
#pragma unroll
                for (int mm = 0; mm < NB; ++mm)
#pragma unroll
                    for (int bj = 0; bj < 2; ++bj) { const size_t off = (size_t)(row0 + ai * 128 + (mb + mm) * 16) * DM + colb + bj * 128;
                        gv[mm][bj] = *(const u32x4*)(GATE + off); if (ACCUM) ov[mm][bj] = *(const u32x4*)(MRG + off); }
#pragma unroll
                for (int mm = 0; mm < NB; ++mm)
#pragma unroll
                    for (int bj = 0; bj < 2; ++bj) { const int m = mb + mm; const size_t off = (size_t)(row0 + ai * 128 + m * 16) * DM + colb + bj * 128;
                        float v[8], g[8]; EPI_LOAD8(v, ai, bj, m); unpack8(gv[mm][bj], g);
                        if (ACCUM) { float o[8]; unpack8(ov[mm][bj], o);
#pragma unroll
                            for (int i = 0; i < 8; ++i) v[i] = o[i] + g[i] * v[i]; }
                        else {
#pragma unroll
                            for (int i = 0; i < 8; ++i) v[i] = g[i] * v[i]; }
                        *(u32x4*)(MRG + off) = pack8(v); }
            }
    }
};
struct EpiMergeSeg {
    const bf16_t* GA; const bf16_t* GB; bf16_t* MRG;
    __device__ __forceinline__ void operator()(AccT& acc, const pg8::Unit& u, int wr, int wc, int fr, int fq) const {
        const int row0 = u.pm * 256 + wr * 64 + fr, colb = u.pn * 256 + wc * 32 + 8 * fq;
        if (u.kind == 0) {
#pragma unroll
            for (int ai = 0; ai < 2; ++ai) {
                u32x4 bv[4][2];
#pragma unroll
                for (int m = 0; m < 4; ++m)
#pragma unroll
                    for (int bj = 0; bj < 2; ++bj) bv[m][bj] = *(const u32x4*)(GB + (size_t)(row0 + ai * 128 + m * 16) * DM + colb + bj * 128);
#pragma unroll
                for (int m = 0; m < 4; ++m)
#pragma unroll
                    for (int bj = 0; bj < 2; ++bj) { float b[8]; unpack8(bv[m][bj], b);
                        acc[ai][bj][m][0] *= (f32x4){b[0], b[1], b[2], b[3]}; acc[ai][bj][m][1] *= (f32x4){b[4], b[5], b[6], b[7]}; }
            }
        } else {
#pragma unroll
            for (int ai = 0; ai < 2; ++ai) {
                u32x4 av[4][2];
#pragma unroll
                for (int m = 0; m < 4; ++m)
#pragma unroll
                    for (int bj = 0; bj < 2; ++bj) av[m][bj] = *(const u32x4*)(GA + (size_t)(row0 + ai * 128 + m * 16) * DM + colb + bj * 128);
#pragma unroll
                for (int m = 0; m < 4; ++m)
#pragma unroll
                    for (int bj = 0; bj < 2; ++bj) { float v[8], a[8]; EPI_LOAD8(v, ai, bj, m); unpack8(av[m][bj], a);
#pragma unroll
                        for (int i = 0; i < 8; ++i) v[i] *= a[i];
                        *(u32x4*)(MRG + (size_t)(row0 + ai * 128 + m * 16) * DM + colb + bj * 128) = pack8(v); }
            }
        }
    }
};
template <int RES_BF> struct EpiResid {
    const void* RES; bf16_t* XBF; float* PART; const float* RSC;
    __device__ __forceinline__ void operator()(const AccT& acc, const pg8::Unit& u, int wr, int wc, int fr, int fq) const {
        const int row0 = u.pm * 256 + wr * 64 + fr, colb = u.pn * 256 + wc * 32 + 8 * fq;
        constexpr int NB = RES_BF ? 4 : 2;
        constexpr bool SCALED = (RES_BF == 2);
#pragma unroll
        for (int ai = 0; ai < 2; ++ai)
#pragma unroll
            for (int mb = 0; mb < 4; mb += NB) {
                f32x4 rf[NB][2][2]; u32x4 rb[NB][2]; float rsc[NB];
#pragma unroll
                for (int mm = 0; mm < NB; ++mm) rsc[mm] = SCALED ? RSC[row0 + ai * 128 + (mb + mm) * 16] : 1.0f;
#pragma unroll
                for (int mm = 0; mm < NB; ++mm)
#pragma unroll
                    for (int bj = 0; bj < 2; ++bj) { const size_t off = (size_t)(row0 + ai * 128 + (mb + mm) * 16) * DM + colb + bj * 128;
                        if (RES_BF) rb[mm][bj] = *(const u32x4*)((const bf16_t*)RES + off);
                        else { rf[mm][bj][0] = *(const f32x4*)((const float*)RES + off); rf[mm][bj][1] = *(const f32x4*)((const float*)RES + off + 4); } }
#pragma unroll
                for (int mm = 0; mm < NB; ++mm) {
                    const int m = mb + mm, row = row0 + ai * 128 + m * 16; float q = 0.f;
#pragma unroll
                    for (int bj = 0; bj < 2; ++bj) {
                        const size_t off = (size_t)row * DM + colb + bj * 128;
                        float v[8], r[8]; EPI_LOAD8(v, ai, bj, m);
                        if (RES_BF) unpack8(rb[mm][bj], r);
                        else {
#pragma unroll
                            for (int i = 0; i < 4; ++i) { r[i] = rf[mm][bj][0][i]; r[4 + i] = rf[mm][bj][1][i]; } }
#pragma unroll
                        for (int i = 0; i < 8; ++i) { v[i] += SCALED ? r[i] * rsc[mm] : r[i]; q += v[i] * v[i]; }
                        *(u32x4*)(XBF + off) = pack8(v);
                    }
                    q += __shfl_xor(q, 16); q += __shfl_xor(q, 32);
                    if (fq == 0) PART[(size_t)row * 16 + u.pn * 4 + wc] = q;
                }
            }
    }
};
struct EpiFinal {
    const bf16_t* RES; float* OUT; float* PART; unsigned* CNT; const float* gf;
    __device__ __forceinline__ void operator()(const AccT& acc, const pg8::Unit& u, int wr, int wc, int fr, int fq) const {
        const int row0 = u.pm * 256 + wr * 64 + fr, colb = u.pn * 256 + wc * 32 + 8 * fq;
        f32x4 xv[2][2][4][2];
#pragma unroll
        for (int ai = 0; ai < 2; ++ai) {
            u32x4 rb[4][2];
#pragma unroll
            for (int m = 0; m < 4; ++m)
#pragma unroll
                for (int bj = 0; bj < 2; ++bj) rb[m][bj] = *(const u32x4*)(RES + (size_t)(row0 + ai * 128 + m * 16) * DM + colb + bj * 128);
#pragma unroll
            for (int m = 0; m < 4; ++m) {
                const int row = row0 + ai * 128 + m * 16; float q = 0.f;
#pragma unroll
                for (int bj = 0; bj < 2; ++bj) {
                    float v[8], r[8]; EPI_LOAD8(v, ai, bj, m); unpack8(rb[m][bj], r);
#pragma unroll
                    for (int i = 0; i < 8; ++i) { v[i] += r[i]; q += v[i] * v[i]; }
                    xv[ai][bj][m][0] = (f32x4){v[0], v[1], v[2], v[3]}; xv[ai][bj][m][1] = (f32x4){v[4], v[5], v[6], v[7]};
                }
                q += __shfl_xor(q, 16); q += __shfl_xor(q, 32);
                if (fq == 0) __hip_atomic_store(PART + (size_t)row * 16 + u.pn * 4 + wc, q, __ATOMIC_RELAXED, __HIP_MEMORY_SCOPE_AGENT);
            }
        }
        asm volatile("s_waitcnt vmcnt(0)" ::: "memory");
        __builtin_amdgcn_s_barrier();
        if (threadIdx.x == 0) {
            unsigned* cnt = CNT + 64 * u.pm;
            __hip_atomic_fetch_add(cnt, 1u, __ATOMIC_RELAXED, __HIP_MEMORY_SCOPE_AGENT);
            unsigned sp = 0;
            while (__hip_atomic_load(cnt, __ATOMIC_RELAXED, __HIP_MEMORY_SCOPE_AGENT) < 4u) { __builtin_amdgcn_s_sleep(1); if (++sp > (1u << 22)) break; }
            __builtin_amdgcn_fence(__ATOMIC_ACQUIRE, "agent");
            asm volatile("s_waitcnt vmcnt(0)" ::: "memory");
        }
        asm volatile("" ::: "memory");
        __builtin_amdgcn_s_barrier();
        asm volatile("" ::: "memory");
#pragma unroll
        for (int ai = 0; ai < 2; ++ai) {
            f32x4 pv[4];
#pragma unroll
            for (int m = 0; m < 4; ++m) pv[m] = *(const f32x4*)(PART + (size_t)(row0 + ai * 128 + m * 16) * 16 + 4 * fq);
            f32x4 gq[2][2];
#pragma unroll
            for (int bj = 0; bj < 2; ++bj) { gq[bj][0] = *(const f32x4*)(gf + colb + bj * 128); gq[bj][1] = *(const f32x4*)(gf + colb + bj * 128 + 4); }
#pragma unroll
            for (int m = 0; m < 4; ++m) {
                float ss = (pv[m][0] + pv[m][1]) + (pv[m][2] + pv[m][3]); ss += __shfl_xor(ss, 16); ss += __shfl_xor(ss, 32);
                const float rs = 1.0f / sqrtf(ss * (1.0f / DM) + EPSV);
#pragma unroll
                for (int bj = 0; bj < 2; ++bj) {
                    float* o = OUT + (size_t)(row0 + ai * 128 + m * 16) * DM + colb + bj * 128;
                    *(f32x4*)o = xv[ai][bj][m][0] * rs * gq[bj][0]; *(f32x4*)(o + 4) = xv[ai][bj][m][1] * rs * gq[bj][1];
                }
            }
        }
    }
};
struct EpiGateUp {
    const LAS float* RSL; bf16_t* ACT;
    __device__ __forceinline__ void operator()(const AccT& acc, const pg8::Unit& u, int wr, int wc, int fr, int fq) const {
        const int row0 = u.pm * 256 + wr * 64 + fr, colb = u.pn * 128 + wc * 32 + 8 * fq;
        float rs8[2][4];
#pragma unroll
        for (int ai = 0; ai < 2; ++ai)
#pragma unroll
            for (int m = 0; m < 4; ++m) rs8[ai][m] = RSL[u.idx * 256 + ai * 128 + wr * 64 + m * 16 + fr] * ((MK_REPEAT) == 20 ? 0.5f : 1.0f);
#pragma unroll
        for (int ai = 0; ai < 2; ++ai)
#pragma unroll
            for (int m = 0; m < 4; ++m) {
                const int row = row0 + ai * 128 + m * 16; const float rs = rs8[ai][m];
                const float rsl = rs * (-1.442695041f), rs2 = rs * rs;
                float gt[8], up[8], o[8]; EPI_LOAD8(gt, ai, 0, m); EPI_LOAD8(up, ai, 1, m);
#pragma unroll
                for (int i = 0; i < 8; i += 2) {
                    const f32x2 g2 = {gt[i], gt[i + 1]}, u2 = {up[i], up[i + 1]};
                    const f32x2 t = g2 * rsl; f32x2 e; e.x = __builtin_amdgcn_exp2f(t.x); e.y = __builtin_amdgcn_exp2f(t.y);
                    const f32x2 d = e + 1.0f; f32x2 r; r.x = __builtin_amdgcn_rcpf(d.x); r.y = __builtin_amdgcn_rcpf(d.y);
                    const f32x2 w = ((g2 * u2) * r) * rs2; o[i] = w.x; o[i + 1] = w.y;
                }
                *(u32x4*)(ACT + (size_t)row * FFH + colb) = pack8(o);
            }
    }
};

struct Ctx { LAS unsigned char* lds; int tid, lane, wave, G, bx; };

__device__ __forceinline__ void p0_convert_x(const Ctx& c, const float* x, bf16_t* XB, float* rstd1) {
    for (int base = c.bx * 128; base < T_TOK; base += c.G * 128) {
        for (int rr = 0; rr < 16; rr += 4) {
            const int row0 = base + c.wave * 16 + rr;
            f32x4 v[4][4];
#pragma unroll
            for (int r = 0; r < 4; ++r)
#pragma unroll
                for (int j = 0; j < 4; ++j) v[r][j] = __builtin_nontemporal_load((const f32x4*)(x + (size_t)(row0 + r) * DM + j * 256 + c.lane * 4));
#pragma unroll
            for (int r = 0; r < 4; ++r) {
                float q = 0.f;
#pragma unroll
                for (int j = 0; j < 4; ++j) q += v[r][j][0] * v[r][j][0] + v[r][j][1] * v[r][j][1] + v[r][j][2] * v[r][j][2] + v[r][j][3] * v[r][j][3];
#pragma unroll
                for (int o = 32; o >= 1; o >>= 1) q += __shfl_xor(q, o);
                const float rms = sqrtf(q * (1.0f / DM) + EPSV), rs = 1.0f / rms;
                if (c.lane == 0) rstd1[row0 + r] = rms;
#pragma unroll
                for (int j = 0; j < 4; ++j) *(u32x2*)(XB + (size_t)(row0 + r) * DM + j * 256 + c.lane * 4) = (u32x2){cvt_pk_bf16(v[r][j][0] * rs, v[r][j][1] * rs), cvt_pk_bf16(v[r][j][2] * rs, v[r][j][3] * rs)};
            }
        }
    }
}
__device__ __forceinline__ void transpose_quad(const Ctx& c, const float* W, int K, int N, const float* gs, bf16_t* Wt, int ldw, int map, int tk4, int tn) {
    LAS float* tile = (LAS float*)c.lds;
    const int k0 = tk4 * 256, n0 = tn * 64, nn = c.tid & 63, kq = c.tid >> 6;
    float v[32];
#pragma unroll
    for (int e = 0; e < 32; ++e) v[e] = W[(size_t)(k0 + kq + 8 * e) * N + n0 + nn];
    if (gs) {
#pragma unroll
        for (int e = 0; e < 32; ++e) v[e] *= gs[k0 + kq + 8 * e];
    }
#pragma unroll
    for (int e = 0; e < 32; ++e) tile[(kq + 8 * e) * 65 + nn] = v[e];
    __syncthreads();
    { const int ks = kq * 32; const int n = n0 + nn; const int dn = map == 0 ? n : (map == 3 ? (n < 2560 ? n : (n < 3584 ? 2560 + 256 * ((n - 2560) >> 7) + ((n - 2560) & 127) : 2560 + 256 * ((n - 3584) >> 7) + 128 + ((n - 3584) & 127))) : (256 * (n >> 7) + (n & 127) + (map == 2 ? 128 : 0)));
        bf16_t* dst = Wt + (size_t)dn * ldw + k0 + ks;
#pragma unroll
        for (int q = 0; q < 4; ++q) { float f[8];
#pragma unroll
            for (int j = 0; j < 8; ++j) f[j] = tile[(ks + q * 8 + j) * 65 + nn];
            *(u32x4*)(dst + q * 8) = pack8(f); } }
    __syncthreads();
}
__device__ __forceinline__ void p0_weights(const Ctx& c, const Params& p, int j0, int j1, int first, int nblk) {
    unsigned char* ws = p.ws;
    if (c.bx < first || c.bx >= first + nblk) return;
    for (int job = j0 + (c.bx - first); job < j1; job += nblk) {
        const float* W; int K, N, map = 0, t = job, ldw = 0; const float* gs = nullptr; bf16_t* Wt;
        if (job < 288) { W = p.in[2]; K = 1024; N = 4608; gs = p.in[1]; Wt = (bf16_t*)(ws + WS_WIN); map = 3; }
        else if (job < 304) { t = job - 288; W = p.in[15]; K = 512; N = 512; Wt = (bf16_t*)(ws + WS_WGLU); }
        else if (job < 368) { t = job - 304; W = p.in[17]; K = 1024; N = 1024; Wt = (bf16_t*)(ws + WS_PA); }
        else if (job < 400) { t = job - 368; W = p.in[18]; K = 512; N = 1024; Wt = (bf16_t*)(ws + WS_PB); ldw = 1024; }
        else if (job < 464) { t = job - 400; W = p.in[19]; K = 1024; N = 1024; Wt = (bf16_t*)(ws + WS_WOUT); }
        else if (job < 640) { t = job - 464; W = p.in[21]; K = 1024; N = 2816; gs = p.in[20]; Wt = (bf16_t*)(ws + WS_WGU); map = 1; }
        else if (job < 816) { t = job - 640; W = p.in[22]; K = 1024; N = 2816; gs = p.in[20]; Wt = (bf16_t*)(ws + WS_WGU); map = 2; }
        else { t = job - 816; W = p.in[23]; K = 2816; N = 1024; Wt = (bf16_t*)(ws + WS_WD); }
        const int nk = K / 256;
        transpose_quad(c, W, K, N, gs, Wt, ldw ? ldw : K, map, t % nk, t / nk);
    }
}
__device__ __forceinline__ void p0_s5_tables(const Ctx& c, const Params& p) {
    LAS float* AP = (LAS float*)c.lds;
    LAS float* BB = AP + 33 * 64 * 2;
    LAS float* CC = BB + 64 * 16 * 2;
    LAS float* DD = CC + 16 * 64 * 2;
    unsigned char* ws = p.ws;
    float* KTAB = (float*)(ws + WS_KTAB); bf16_t* M1 = (bf16_t*)(ws + WS_M1); bf16_t* TOEP = (bf16_t*)(ws + WS_TOEP); float* A32 = (float*)(ws + WS_A32);
    for (int item = c.bx; item < 256; item += c.G) {
        const int g = item >> 3, r = item & 7;
        __syncthreads();
        if (c.tid < 64) {
            const int pi = c.tid;
            const float dt = expf(p.in[9][g]), lr = p.in[7][g * 64 + pi], li = p.in[8][g * 64 + pi];
            const float mag = expf(lr * dt), are = mag * cosf(li * dt), aim = mag * sinf(li * dt);
            const float den = lr * lr + li * li, nr = are - 1.0f;
            const float cre = (nr * lr + aim * li) / den, cim = (aim * lr - nr * li) / den;
            for (int h = 0; h < 16; ++h) { const float br = p.in[10][(g * 64 + pi) * 16 + h], bi = p.in[11][(g * 64 + pi) * 16 + h];
                BB[(pi * 16 + h) * 2] = cre * br - cim * bi; BB[(pi * 16 + h) * 2 + 1] = cre * bi + cim * br; }
            float pr = 1.f, pim = 0.f;
            for (int k = 0; k <= 32; ++k) { AP[(k * 64 + pi) * 2] = pr; AP[(k * 64 + pi) * 2 + 1] = pim; const float t0 = pr * are - pim * aim, t1 = pr * aim + pim * are; pr = t0; pim = t1; }
        }
        for (int e = c.tid; e < 1024; e += NTHR) { const int h = e >> 6, pi = e & 63; CC[e * 2] = p.in[12][(g * 16 + h) * 64 + pi]; CC[e * 2 + 1] = p.in[13][(g * 16 + h) * 64 + pi]; }
        if (c.tid < 16) DD[c.tid] = p.in[14][g * 16 + c.tid];
        __syncthreads();
        if (r == 0 && c.tid < 64) { A32[(g * 64 + c.tid) * 2] = AP[(32 * 64 + c.tid) * 2]; A32[(g * 64 + c.tid) * 2 + 1] = AP[(32 * 64 + c.tid) * 2 + 1]; }
        for (int e = c.tid; e < 1024; e += NTHR) {
            const int lag = 4 * r + (e >> 8), ho = (e >> 4) & 15, hi = e & 15; float s = 0.f;
            for (int pi = 0; pi < 64; ++pi) {
                const float ar = AP[(lag * 64 + pi) * 2], ai = AP[(lag * 64 + pi) * 2 + 1], br = BB[(pi * 16 + hi) * 2], bi = BB[(pi * 16 + hi) * 2 + 1];
                const float wre = ar * br - ai * bi, wim = ar * bi + ai * br;
                s += CC[(ho * 64 + pi) * 2] * wre - CC[(ho * 64 + pi) * 2 + 1] * wim;
            }
            if (lag == 0 && ho == hi) s += DD[ho];
            KTAB[(size_t)(g * 32 + lag) * 256 + ho * 16 + hi] = s;
        }
        for (int e = c.tid; e < 8192; e += NTHR) {
            const int row = 16 * r + (e >> 9), k = e & 511, pi = row & 63, s = k >> 4, hi = k & 15;
            const float ar = AP[((31 - s) * 64 + pi) * 2], ai = AP[((31 - s) * 64 + pi) * 2 + 1], br = BB[(pi * 16 + hi) * 2], bi = BB[(pi * 16 + hi) * 2 + 1];
            const float v = (row < 64) ? (ar * br - ai * bi) : (ar * bi + ai * br);
            M1[((size_t)g * 128 + row) * 512 + k] = (bf16_t)(cvt_pk_bf16(v, 0.f) & 0xffffu);
        }
        for (int e = c.tid; e < 8192; e += NTHR) {
            const int rl = e >> 7, q = e & 127, t = 4 * r + (rl >> 4), ho = rl & 15, pi = q & 63;
            const float ar = AP[((t + 1) * 64 + pi) * 2], ai = AP[((t + 1) * 64 + pi) * 2 + 1], cr = CC[(ho * 64 + pi) * 2], ci = CC[(ho * 64 + pi) * 2 + 1];
            const float v = (q < 64) ? (cr * ar - ci * ai) : -(cr * ai + ci * ar);
            TOEP[((size_t)g * 512 + t * 16 + ho) * XGW + 512 + q] = (bf16_t)(cvt_pk_bf16(v, 0.f) & 0xffffu);
        }
    }
    __syncthreads();
}
__device__ __forceinline__ void p0_wm(const Ctx& c, const float* wsp, bf16_t* WM) {
    for (int e = c.bx * NTHR + c.tid; e < 8 * 128 * 128; e += c.G * NTHR) {
        const int i = (e >> 7) & 127, j = e & 127; const float v = ((j >> 6) <= (i >> 6)) ? wsp[e] : 0.f;
        WM[e] = (bf16_t)(cvt_pk_bf16(v, 0.f) & 0xffffu);
    }
}
__device__ __forceinline__ void p2_gmlp_mix(const Ctx& c, const Params& p, int nb0, int nbstride) {
    unsigned char* ws = p.ws;
    const bf16_t* U = (const bf16_t*)(ws + WS_R1); const bf16_t* V = (const bf16_t*)(ws + WS_R2); bf16_t* YA = (bf16_t*)(ws + WS_R0);
    const float* VSTAT = (const float*)(ws + WS_VSTAT); const bf16_t* WM = (const bf16_t*)(ws + WS_WM);
    const float* lng = p.in[3]; const float* lnb = p.in[4]; const float* bs = p.in[6];
    LAS float* MU = (LAS float*)(c.lds + 2 * 128 * 272);
    const int fr = c.lane & 15, fq = c.lane >> 4, wi = c.wave >> 1, wj = c.wave & 1;
    const int c8 = c.tid & 15, jb = c.tid >> 4;
    for (int nb = nb0; nb < 256; nb += nbstride) {
        const int tok0 = nb * 128;
        u32x4 vr[4];
#pragma unroll
        for (int e = 0; e < 4; ++e) vr[e] = *(const u32x4*)(V + (size_t)(tok0 + jb + 32 * e) * DM + c8 * 8);
        __syncthreads();
        if (c.tid < 128) {
            const f32x4* sp = (const f32x4*)(VSTAT + (size_t)(tok0 + c.tid) * 32); float s = 0.f, q = 0.f;
#pragma unroll
            for (int i = 0; i < 8; ++i) { const f32x4 w = sp[i]; s += w[0] + w[2]; q += w[1] + w[3]; }
            const float mu = s * (1.0f / DM), var = fmaxf(q * (1.0f / DM) - mu * mu, 0.f);
            MU[c.tid] = mu; MU[128 + c.tid] = 1.0f / sqrtf(var + EPSV);
        }
        __syncthreads();
        float mu4[4], rs4[4];
#pragma unroll
        for (int e = 0; e < 4; ++e) { mu4[e] = MU[jb + 32 * e]; rs4[e] = MU[128 + jb + 32 * e]; }
        for (int g = 0; g < 8; ++g) {
            LAS bf16_t* VT = (LAS bf16_t*)(c.lds + (g & 1) * 128 * 272);
            { const int ch = g * 128 + c8 * 8;
                const f32x4 g0 = *(const f32x4*)(lng + ch), g1 = *(const f32x4*)(lng + ch + 4), b0 = *(const f32x4*)(lnb + ch), b1 = *(const f32x4*)(lnb + ch + 4);
#pragma unroll
                for (int e = 0; e < 4; ++e) {
                    const int j = jb + 32 * e; float v[8]; unpack8(vr[e], v);
#pragma unroll
                    for (int i = 0; i < 8; ++i) { const float vn = (v[i] - mu4[e]) * rs4[e] * (i < 4 ? g0[i & 3] : g1[i & 3]) + (i < 4 ? b0[i & 3] : b1[i & 3]);
                        VT[(c8 * 8 + i) * 136 + j] = (bf16_t)(cvt_pk_bf16(vn, 0.f) & 0xffffu); }
                }
            }
            if (g < 7) {
#pragma unroll
                for (int e = 0; e < 4; ++e) vr[e] = *(const u32x4*)(V + (size_t)(tok0 + jb + 32 * e) * DM + (g + 1) * 128 + c8 * 8);
            }
            u32x4 uu[2][2]; float bsv[2];
#pragma unroll
            for (int mf = 0; mf < 2; ++mf) { const int i = 32 * wi + 16 * mf + fr; bsv[mf] = bs[g * 128 + i];
#pragma unroll
                for (int k = 0; k < 2; ++k) uu[mf][k] = *(const u32x4*)(U + (size_t)(tok0 + i) * DM + g * 128 + 64 * wj + 32 * k + 8 * fq); }
            bf16x8 af[4][2];
#pragma unroll
            for (int kk = 0; kk < 4; ++kk)
#pragma unroll
                for (int mf = 0; mf < 2; ++mf) af[kk][mf] = *(const bf16x8*)(WM + ((size_t)g * 128 + 32 * wi + 16 * mf + fr) * 128 + 32 * kk + 8 * fq);
            __syncthreads();
            f32x4 acc[2][4];
#pragma unroll
            for (int a = 0; a < 2; ++a)
#pragma unroll
                for (int b = 0; b < 4; ++b) acc[a][b] = (f32x4){0.f, 0.f, 0.f, 0.f};
#pragma unroll
            for (int kk = 0; kk < 4; ++kk) {
                bf16x8 bfr[4];
#pragma unroll
                for (int nf = 0; nf < 4; ++nf) bfr[nf] = *(const LAS bf16x8*)(VT + (64 * wj + 32 * (nf >> 1) + 8 * (fr >> 2) + 4 * (nf & 1) + (fr & 3)) * 136 + 32 * kk + 8 * fq);
#pragma unroll
                for (int mf = 0; mf < 2; ++mf)
#pragma unroll
                    for (int nf = 0; nf < 4; ++nf) acc[mf][nf] = __builtin_amdgcn_mfma_f32_16x16x32_bf16(bfr[nf], af[kk][mf], acc[mf][nf], 0, 0, 0);
            }
#pragma unroll
            for (int mf = 0; mf < 2; ++mf) {
                const int i = 32 * wi + 16 * mf + fr;
#pragma unroll
                for (int k = 0; k < 2; ++k) {
                    const size_t off = (size_t)(tok0 + i) * DM + g * 128 + 64 * wj + 32 * k + 8 * fq;
                    float uv[8], o[8]; unpack8(uu[mf][k], uv); gelu8(uv);
#pragma unroll
                    for (int r = 0; r < 4; ++r) { o[r] = uv[r] * (acc[mf][2 * k][r] + bsv[mf]); o[4 + r] = uv[4 + r] * (acc[mf][2 * k + 1][r] + bsv[mf]); }
                    *(u32x4*)(YA + off) = pack8(o);
                }
            }
        }
    }
    __syncthreads();
}
__device__ __forceinline__ void p2_toeplitz(const Ctx& c, const Params& p) {
    const float* KTAB = (const float*)(p.ws + WS_KTAB); bf16_t* TOEP = (bf16_t*)(p.ws + WS_TOEP);
    for (int item = c.bx; item < 256; item += c.G) {
        const int g = item >> 3, r = item & 7;
#pragma unroll
        for (int e = 0; e < 8; ++e) {
            const int idx = c.tid + NTHR * e; const int rl = idx >> 6, c8 = idx & 63;
            const int t = 4 * r + (rl >> 4), ho = rl & 15, s = c8 >> 1, hi0 = (c8 & 1) * 8;
            u32x4 o = (u32x4){0u, 0u, 0u, 0u};
            if (s <= t) { const float* kp = KTAB + (size_t)(g * 32 + (t - s)) * 256 + ho * 16 + hi0; const f32x4 k0 = *(const f32x4*)kp, k1 = *(const f32x4*)(kp + 4);
                o = (u32x4){cvt_pk_bf16(k0[0], k0[1]), cvt_pk_bf16(k0[2], k0[3]), cvt_pk_bf16(k1[0], k1[1]), cvt_pk_bf16(k1[2], k1[3])}; }
            *(u32x4*)(TOEP + ((size_t)g * 512 + t * 16 + ho) * XGW + s * 16 + hi0) = o;
        }
    }
}
__device__ __forceinline__ void s5_scan_item(const Ctx& c, const Params& p, int item) {
    const float* S = (const float*)(p.ws + WS_S); const float* A32 = (const float*)(p.ws + WS_A32); bf16_t* XGE = (bf16_t*)(p.ws + WS_XGE);
    LAS float* L = (LAS float*)c.lds;
    int tid = c.tid; asm volatile("" : "+v"(tid));
    const int g = item >> 2, b = item & 3; const size_t row0 = (size_t)g * NCH + b * NCHB;
    __syncthreads();
    const f32x4* src = (const f32x4*)(S + row0 * 128);
#pragma unroll
    for (int e = 0; e < 16; ++e) { const int idx = tid + NTHR * e; *(LAS f32x4*)(L + idx * 4) = src[idx]; }
    __syncthreads();
    if (tid < 64) {
        const int pi = tid; const float ar = A32[(g * 64 + pi) * 2], ai = A32[(g * 64 + pi) * 2 + 1]; float hr = 0.f, him = 0.f;
        bf16_t* dst = XGE + row0 * XGW + 512 + pi;
#pragma unroll 8
        for (int ch = 0; ch < NCHB; ++ch) {
            const float sr = L[ch * 128 + pi], si = L[ch * 128 + 64 + pi];
            const unsigned w = cvt_pk_bf16(hr, him);
            dst[(size_t)ch * XGW] = (bf16_t)(w & 0xffffu); dst[(size_t)ch * XGW + 64] = (bf16_t)(w >> 16);
            const float t0 = ar * hr - ai * him + sr, t1 = ar * him + ai * hr + si; hr = t0; him = t1;
        }
    }
    asm volatile("s_waitcnt vmcnt(0)" ::: "memory");
    __syncthreads();
}
__device__ __forceinline__ void p10_final_norm(const Ctx& c, const Params& p) {
    const float* PART = (const float*)(p.ws + WS_RSFP); const float* gf = p.in[24]; float* out = p.out; const bf16_t* X2 = (const bf16_t*)(p.ws + WS_R4);
    f32x4 gv[2][2];
#pragma unroll
    for (int j = 0; j < 2; ++j) { gv[j][0] = *(const f32x4*)(gf + j * 512 + c.lane * 8); gv[j][1] = *(const f32x4*)(gf + j * 512 + c.lane * 8 + 4); }
    for (int row = c.bx * 8 + c.wave; row < T_TOK; row += c.G * 8) {
        const f32x4* pp = (const f32x4*)(PART + (size_t)row * 16); const f32x4 p0 = pp[0], p1 = pp[1], p2 = pp[2], p3 = pp[3];
        const u32x4 w0 = *(const u32x4*)(X2 + (size_t)row * DM + c.lane * 8), w1 = *(const u32x4*)(X2 + (size_t)row * DM + 512 + c.lane * 8);
        const float ss = ((p0[0] + p0[1]) + (p0[2] + p0[3])) + ((p1[0] + p1[1]) + (p1[2] + p1[3])) + ((p2[0] + p2[1]) + (p2[2] + p2[3])) + ((p3[0] + p3[1]) + (p3[2] + p3[3]));
        const float rs = 1.0f / sqrtf(ss * (1.0f / DM) + EPSV);
        float* xr = out + (size_t)row * DM;
        float a[8], b[8]; unpack8(w0, a); unpack8(w1, b);
        __builtin_nontemporal_store((f32x4){a[0], a[1], a[2], a[3]} * rs * gv[0][0], (f32x4*)(xr + c.lane * 8));
        __builtin_nontemporal_store((f32x4){a[4], a[5], a[6], a[7]} * rs * gv[0][1], (f32x4*)(xr + c.lane * 8 + 4));
        __builtin_nontemporal_store((f32x4){b[0], b[1], b[2], b[3]} * rs * gv[1][0], (f32x4*)(xr + 512 + c.lane * 8));
        __builtin_nontemporal_store((f32x4){b[4], b[5], b[6], b[7]} * rs * gv[1][1], (f32x4*)(xr + 512 + c.lane * 8 + 4));
    }
}

__global__ void __launch_bounds__(NTHR, 2) hybrid_fwd(Params p) {
    extern __shared__ __attribute__((aligned(16))) unsigned char shm[];
    Ctx c; c.lds = (LAS unsigned char*)shm; c.tid = threadIdx.x; c.lane = c.tid & 63; c.wave = __builtin_amdgcn_readfirstlane(c.tid >> 6); c.G = gridDim.x; c.bx = blockIdx.x;
    unsigned char* ws = p.ws;
    const int lo = p.ph_lo, hi = p.ph_hi;
#ifndef MK_ONLYPH
#define MK_ONLYPH -1
#endif
#define IN(k) ((MK_ONLYPH) < 0 ? (lo <= (k) && (k) < hi) : ((k) == (MK_ONLYPH)))
    if (c.tid < 4) ((LAS unsigned*)(c.lds + LDS_STAGE))[c.tid] = 0u;
    __syncthreads();
    XcdBarrier bar = xcd_barrier_post((unsigned*)(ws + WS_BAR), (volatile LAS unsigned*)(c.lds + LDS_STAGE));
    if (p.ph_hi > 1000) cg::this_grid().sync();
#define GSYNC() xcd_barrier(bar)
#define SEAM(k) do { if (IN(k) && IN((k) + 1)) GSYNC(); } while (0)
#define REP(k) for (int _r = 0; _r < ((MK_REPEAT) == (k) ? 2 : 1); ++_r)
#define REPSYNC(k) do { if ((MK_REPEAT) == (k) && _r == 0) GSYNC(); } while (0)
    bf16_t* R0 = (bf16_t*)(ws + WS_R0); bf16_t* R1 = (bf16_t*)(ws + WS_R1); bf16_t* R2 = (bf16_t*)(ws + WS_R2); bf16_t* R3 = (bf16_t*)(ws + WS_R3); bf16_t* R4 = (bf16_t*)(ws + WS_R4);
    bf16_t* XGE = (bf16_t*)(ws + WS_XGE); bf16_t* YB0 = (bf16_t*)p.out; bf16_t* YB = YB0 + (size_t)T_TOK * S5W;
    if (IN(0)) REP(0) {
        if (c.bx & 8) {
            p0_s5_tables(c, p);
            p0_wm(c, p.in[5], (bf16_t*)(ws + WS_WM));
            p0_convert_x(c, p.in[0], (bf16_t*)(ws + WS_XB), (float*)(ws + WS_RSTD1));
            p0_weights(c, p, 0, 288, 0, c.G);
        } else {
            p0_convert_x(c, p.in[0], (bf16_t*)(ws + WS_XB), (float*)(ws + WS_RSTD1));
            p0_weights(c, p, 0, 288, 0, c.G);
            p0_s5_tables(c, p);
            p0_wm(c, p.in[5], (bf16_t*)(ws + WS_WM));
        }
        REPSYNC(0);
    }
    SEAM(0);
    if (IN(1)) REP(1) {
        p2_toeplitz(c, p);
        pg8::Gemm g{(const bf16_t*)(ws + WS_XB), (const bf16_t*)(ws + WS_WIN), DM, DM, DM}; pg8::StaticOrder S; S.init(T_TOK, INW, c.G, c.bx, MK_WGM_BIG);
        EpiProj E{(const float*)(ws + WS_RSTD1), R1, R2, (float*)(ws + WS_VSTAT), XGE, R3, R4};
        pg8::gemm_phase(c.lds, g, S, E);
        REPSYNC(1);
    }
    SEAM(1);
    if (IN(2)) {
        const int nc = (c.G >= 256) ? 128 : (c.G > 1 ? c.G / 2 : 1), ng = c.G - nc;
        constexpr int NW1 = 704;
        if (c.bx < nc || ng <= 0) {
#pragma nounroll
            for (int pm = __builtin_amdgcn_readfirstlane(c.bx); pm < 128; pm += nc) {
                { pg8::Gemm g{XGE, (const bf16_t*)(ws + WS_M1), 512, XGW, 512}; pg8::OneStateUnit S{pm}; EpiState E{(float*)(ws + WS_S)}; pg8::gemm_phase(c.lds, g, S, E); }
                s5_scan_item(c, p, pm);
                { pg8::Gemm g{XGE, (const bf16_t*)(ws + WS_TOEP), XGW, XGW, XGW}; pg8::PanelPair S{pm}; EpiS5Out E{YB0}; pg8::gemm_phase(c.lds, g, S, E); }
            }
            if (ng > 0) p0_weights(c, p, 288, 288 + NW1, 0, nc); else { p0_weights(c, p, 288, 992, 0, nc); p2_gmlp_mix(c, p, c.bx, nc); }
        } else {
            p0_weights(c, p, 288 + NW1, 992, nc, ng);
            p2_gmlp_mix(c, p, c.bx - nc, ng);
        }
    }
    do { if (IN(2) && IN(5)) GSYNC(); } while (0);
    if (IN(5)) REP(5) {
        pg8::Gemm g{YB0, (const bf16_t*)(ws + WS_WGLU), S5W, S5W, S5W}; pg8::StaticOrder S; S.init(T_TOK, S5W, c.G, c.bx); EpiGlu E{YB0, YB, p.in[16], DM};
        pg8::gemm_phase(c.lds, g, S, E);
        REPSYNC(5);
    }
    SEAM(5);
    if (IN(6)) {
        pg8::SegOrder S; S.S.init(T_TOK, DM, c.G, c.bx); S.a0 = (const char*)YB; S.b0 = (const char*)(ws + WS_PB); S.a1 = (const char*)R0; S.b1 = (const char*)(ws + WS_PA); S.pitch = (size_t)DM * 2;
        pg8::Gemm g{nullptr, nullptr, DM, DM, DM}; EpiMergeSeg E{R3, R4, R1};
        pg8::gemm_phase<1, true>(c.lds, g, S, E);
    }
    SEAM(6);
    if (IN(7)) REP(7) {
        pg8::Gemm g{R1, (const bf16_t*)(ws + WS_WOUT), DM, DM, DM}; pg8::StaticOrder S; S.init(T_TOK, DM, c.G, c.bx);
        EpiResid<2> E{ws + WS_XB, R0, (float*)(ws + WS_RS2P), (const float*)(ws + WS_RSTD1)};
        pg8::gemm_phase(c.lds, g, S, E);
        REPSYNC(7);
    }
    SEAM(7);
    if (IN(8)) REP(8) {
        pg8::Gemm g{R0, (const bf16_t*)(ws + WS_WGU), DM, DM, DM}; pg8::StaticOrder S; S.init(T_TOK, 2 * FFH, c.G, c.bx, MK_WGM_BIG);
        LAS float* RSL = (LAS float*)(c.lds + LDS_RSTD);
        {
            const float* PART = (const float*)(ws + WS_RS2P); pg8::Unit u;
            for (int i = 0; i < 12 && S.next(i, u); ++i)
                if (c.tid < 256) { const f32x4* pp = (const f32x4*)(PART + (size_t)(u.pm * 256 + c.tid) * 16); const f32x4 p0 = pp[0], p1 = pp[1], p2 = pp[2], p3 = pp[3];
                    const float ss = ((p0[0] + p0[1]) + (p0[2] + p0[3])) + ((p1[0] + p1[1]) + (p1[2] + p1[3])) + ((p2[0] + p2[1]) + (p2[2] + p2[3])) + ((p3[0] + p3[1]) + (p3[2] + p3[3]));
                    RSL[i * 256 + c.tid] = __builtin_amdgcn_rsqf(ss * (1.0f / DM) + EPSV); }
            __syncthreads();
        }
        EpiGateUp E{RSL, R1};
        pg8::gemm_phase<((MK_REPEAT) == 20 ? 2 : ((MK_REPEAT) == 21 ? -1 : 1))>(c.lds, g, S, E);
        REPSYNC(8);
    }
    SEAM(8);
    if (IN(9)) {
        pg8::Gemm g{R1, (const bf16_t*)(ws + WS_WD), FFH, FFH, FFH}; pg8::StaticOrder S; S.init(T_TOK, DM, c.G, c.bx);
        if (c.G == 256) {
            EpiFinal E{R0, p.out, (float*)(ws + WS_RSFP), (unsigned*)(ws + WS_PCNT), p.in[24]};
            pg8::gemm_phase(c.lds, g, S, E);
        } else {
            EpiResid<1> E{R0, R4, (float*)(ws + WS_RSFP), nullptr};
            pg8::gemm_phase(c.lds, g, S, E);
            GSYNC();
            p10_final_norm(c, p);
        }
    }
    if ((MK_REPEAT) == 11) for (int i = 0; i < 8; ++i) GSYNC();
#undef IN
#undef SEAM
}

extern "C" void kernel_launch(void* const* d_in, const int* in_sizes, int n_in, void* d_out, int out_size, void* d_ws, size_t ws_size, hipStream_t stream) {
    static int grid = 0;
    if (grid == 0) {
        if (n_in != 25 || out_size != T_TOK * DM || ws_size < WS_END) { fprintf(stderr, "kernel_launch: unexpected shapes (n_in %d out %d ws %zu)\n", n_in, out_size, ws_size); grid = -1; return; }
        int dev = 0, cus = 0, per_cu = 0;
        hipGetDevice(&dev); hipDeviceGetAttribute(&cus, hipDeviceAttributeMultiprocessorCount, dev);
        if (hipFuncSetAttribute((const void*)hybrid_fwd, hipFuncAttributeMaxDynamicSharedMemorySize, LDS_BYTES) != hipSuccess) { fprintf(stderr, "kernel_launch: hipFuncSetAttribute failed\n"); grid = -1; return; }
        if (hipOccupancyMaxActiveBlocksPerMultiprocessor(&per_cu, (const void*)hybrid_fwd, NTHR, LDS_BYTES) != hipSuccess || per_cu < 1) { fprintf(stderr, "kernel_launch: occupancy query gave %d\n", per_cu); per_cu = 1; }
        (void)hipGetLastError();
        grid = cus;
    }
    if (grid < 0) return;
    Params p{};
    for (int i = 0; i < 25; ++i) p.in[i] = (const float*)d_in[i];
    p.out = (float*)d_out; p.ws = (unsigned char*)d_ws;
    (void)hipMemsetAsync((unsigned char*)d_ws + WS_BAR, 0, 16384 + 128 * 256, stream);
#if MK_PER_PHASE
    for (int ph = 0; ph <= 10; ++ph) { p.ph_lo = ph; p.ph_hi = ph + 1; hipLaunchKernelGGL(hybrid_fwd, dim3(grid), dim3(NTHR), LDS_BYTES, stream, p); }
#else
    p.ph_lo = 0; p.ph_hi = 11;
    void* args[] = {&p};
    hipError_t e = hipLaunchCooperativeKernel((const void*)hybrid_fwd, dim3(grid), dim3(NTHR), args, LDS_BYTES, stream);
    if (e != hipSuccess) fprintf(stderr, "cooperative launch failed: %s (grid %d)\n", hipGetErrorString(e), grid);
#endif
}
```
